# Optimizing an MI355X kernel written in HIP

```python
import jax, jax.numpy as jnp
from jax import lax
import numpy as np

D_MODEL = 1024
BATCH = 8
SEQ = 8192
DEPTH = 2
DEC_BATCH = 16
DEC_SEQ = 4096
PAST_LEN = 128

GRID_W = 64
NA_HEADS = 8
NA_HEAD_DIM = 64
NA_WIN_ROWS = 8
NA_WIN_COLS = 16
NA_W = NA_HEADS * NA_HEAD_DIM
CONV_CH = 512
CONV_WIDTH = 31
MLA_HEADS = 8
MLA_NOPE = 64
MLA_ROPE = 32
MLA_V = 64
Q_LORA = 256
KV_LORA = 128
ROPE_THETA = 10000.0
ATTN_BLOCK = 128
MLA_W = MLA_HEADS * MLA_V
FNET_GROUPS = 4
FNET_GROUP_DIM = 128
FNET_W = FNET_GROUPS * FNET_GROUP_DIM
PLE_DIM = 256
EPS = 1e-6

N_EVEN = (DEPTH + 1) // 2
N_ODD = DEPTH // 2
EVEN_SPLITS = (NA_W, NA_W, NA_W, NA_W, CONV_CH, CONV_CH, CONV_CH)
ODD_SPLITS = (Q_LORA, KV_LORA, MLA_ROPE, MLA_W, FNET_W, FNET_W)
EVEN_IN = sum(EVEN_SPLITS)
ODD_IN = sum(ODD_SPLITS)

kernel_name = "hybrid_natten_conformer_mla_fnet_encoder"


def _split(z, sizes):
    idx = [int(c) for c in np.cumsum(sizes)[:-1]]
    return jnp.split(z, idx, axis=-1)


def _rmsnorm(x, g):
    xf = x.astype(jnp.float32)
    y = xf * lax.rsqrt(jnp.mean(xf * xf, axis=-1, keepdims=True) + EPS)
    return (y * g.astype(jnp.float32)).astype(x.dtype)


def _layernorm(x, g, b):
    xf = x.astype(jnp.float32)
    mu = jnp.mean(xf, axis=-1, keepdims=True)
    var = jnp.mean(jnp.square(xf - mu), axis=-1, keepdims=True)
    y = (xf - mu) * lax.rsqrt(var + EPS)
    return (y * g.astype(jnp.float32) + b.astype(jnp.float32)).astype(x.dtype)


def _rope(x, cos, sin):
    xf = x.astype(jnp.float32)
    x1, x2 = jnp.split(xf, 2, axis=-1)
    return jnp.concatenate([x1 * cos - x2 * sin, x2 * cos + x1 * sin], axis=-1).astype(x.dtype)


def _na_indices(rows):
    kh = min(NA_WIN_ROWS, rows)
    r = np.arange(rows)
    rs = np.clip(r - kh // 2, 0, rows - kh)
    key_r = rs[:, None] + np.arange(kh)[None, :]
    c = np.arange(GRID_W)
    cs = np.clip(c - NA_WIN_COLS // 2, 0, GRID_W - NA_WIN_COLS)
    key_c = cs[:, None] + np.arange(NA_WIN_COLS)[None, :]
    idx = (key_r[:, None, :, None] * GRID_W + key_c[None, :, None, :]).reshape(rows, GRID_W, kh * NA_WIN_COLS)
    dr = key_r - r[:, None] + NA_WIN_ROWS - 1
    dc = key_c - c[:, None] + NA_WIN_COLS - 1
    return (jnp.asarray(idx, jnp.int32), jnp.asarray(dr, jnp.int32), jnp.asarray(dc, jnp.int32))


def _neighbourhood_attention(q, k, v, rpb):
    b, s, h, dh = q.shape
    rows = s // GRID_W
    idx, dr, dc = _na_indices(rows)
    n_keys = idx.shape[-1]
    scale = NA_HEAD_DIM ** -0.5
    q_rows = jnp.moveaxis(q.reshape(b, rows, GRID_W, h, dh), 1, 0)

    def row(args):
        q_r, idx_r, dr_r = args
        kg = jnp.take(k, idx_r, axis=1)
        vg = jnp.take(v, idx_r, axis=1)
        bias = rpb[:, dr_r[None, :, None], dc[:, None, :]].reshape(h, GRID_W, n_keys)
        sc = jnp.einsum('bwhd,bwlhd->bhwl', q_r, kg).astype(jnp.float32) * scale + bias.astype(jnp.float32)[None]
        a = jax.nn.softmax(sc, axis=-1).astype(v.dtype)
        return jnp.einsum('bhwl,bwlhd->bwhd', a, vg)

    out = lax.map(row, (q_rows, idx, dr))
    return jnp.moveaxis(out, 0, 1).reshape(b, s, h * dh)


def _mla_attention(qn, qr, kn, kr, v):
    b, s, h, _ = qn.shape
    nb = s // ATTN_BLOCK
    scale = (MLA_NOPE + MLA_ROPE) ** -0.5
    qn_b = jnp.moveaxis(qn.reshape(b, nb, ATTN_BLOCK, h, MLA_NOPE), 1, 0)
    qr_b = jnp.moveaxis(qr.reshape(b, nb, ATTN_BLOCK, h, MLA_ROPE), 1, 0)

    def blk(args):
        qn_i, qr_i = args
        sc = (jnp.einsum('bqhd,bkhd->bhqk', qn_i, kn)
              + jnp.einsum('bqhr,bkr->bhqk', qr_i, kr)).astype(jnp.float32) * scale
        a = jax.nn.softmax(sc, axis=-1).astype(v.dtype)
        return jnp.einsum('bhqk,bkhd->bqhd', a, v)

    out = lax.map(blk, (qn_b, qr_b))
    return jnp.moveaxis(out, 0, 1).reshape(b, s, h * MLA_V)


def _even_mixer(h, w_in, rpb, dw_w, dw_b, cln_g, cln_b, w_out):
    b, s, _ = h.shape
    z = h @ w_in
    q, k, v, g_a, u_a, u_b, g_b = _split(z, EVEN_SPLITS)
    shp = (b, s, NA_HEADS, NA_HEAD_DIM)
    a_out = _neighbourhood_attention(q.reshape(shp), k.reshape(shp), v.reshape(shp), rpb)
    a_out = a_out * jax.nn.silu(g_a)
    u = u_a * jax.nn.sigmoid(u_b)
    u = lax.conv_general_dilated(u, dw_w[:, None, :], window_strides=(1,),
                                 padding=[(CONV_WIDTH // 2, CONV_WIDTH // 2)],
                                 dimension_numbers=('NWC', 'WIO', 'NWC'),
                                 feature_group_count=CONV_CH) + dw_b
    u = jax.nn.silu(_layernorm(u, cln_g, cln_b)) * jax.nn.silu(g_b)
    return jnp.concatenate([a_out, u], axis=-1) @ w_out


def _odd_mixer(h, w_in, q_norm_g, kv_norm_g, w_uq, w_ukv, w_out):
    b, s, _ = h.shape
    z = h @ w_in
    c_q, c_kv, k_rope, g_c, f_in, g_d = _split(z, ODD_SPLITS)
    pos = jnp.arange(s, dtype=jnp.float32)
    inv_freq = ROPE_THETA ** (-jnp.arange(0, MLA_ROPE, 2, dtype=jnp.float32) / MLA_ROPE)
    ang = pos[:, None] * inv_freq[None, :]
    cos, sin = jnp.cos(ang), jnp.sin(ang)
    q = (_rmsnorm(c_q, q_norm_g) @ w_uq).reshape(b, s, MLA_HEADS, MLA_NOPE + MLA_ROPE)
    qn, qr = q[..., :MLA_NOPE], q[..., MLA_NOPE:]
    qr = _rope(qr, cos[:, None, :], sin[:, None, :])
    kv = (_rmsnorm(c_kv, kv_norm_g) @ w_ukv).reshape(b, s, MLA_HEADS, MLA_NOPE + MLA_V)
    kn, vv = kv[..., :MLA_NOPE], kv[..., MLA_NOPE:]
    kr = _rope(k_rope, cos, sin)
    c_out = _mla_attention(qn, qr, kn, kr, vv) * jax.nn.silu(g_c)
    f = f_in.reshape(b, s, FNET_GROUPS, FNET_GROUP_DIM).astype(jnp.float32)
    f = jnp.fft.fft2(f, axes=(1, 3), norm='ortho').real.reshape(b, s, FNET_W).astype(h.dtype)
    d_out = f * jax.nn.silu(g_d)
    return jnp.concatenate([c_out, d_out], axis=-1) @ w_out


def _trunk(x, p, g_pre, g_post, w_ple, w_ple_gate,
           w_in_e, rpb, dw_w, dw_b, cln_g, cln_b, w_out_e,
           w_in_o, q_norm_g, kv_norm_g, w_uq, w_ukv, w_out_o):
    for i in range(DEPTH):
        h = _rmsnorm(x, g_pre[i])
        j = i // 2
        if i % 2 == 0:
            o = _even_mixer(h, w_in_e[j], rpb[j], dw_w[j], dw_b[j], cln_g[j], cln_b[j], w_out_e[j])
        else:
            o = _odd_mixer(h, w_in_o[j], q_norm_g[j], kv_norm_g[j], w_uq[j], w_ukv[j], w_out_o[j])
        x = x + _rmsnorm(o, g_post[i])
        x = x + jax.nn.sigmoid(x @ w_ple_gate[i]) * (p[i] @ w_ple[i])
    return x


def setup_inputs(seed: int = 0) -> dict:
    key = jax.random.key(seed)
    ks = jax.random.split(key, 24)
    f32 = jnp.float32

    def nrm(k, shape, fan_in):
        return jax.random.normal(k, shape, f32) * (fan_in ** -0.5)

    def gain(k, shape):
        return 1.0 + 0.02 * jax.random.normal(k, shape, f32)

    return {
        "x_prompt": jax.random.normal(ks[0], (BATCH, SEQ, D_MODEL), f32),
        "x_sample": jax.random.normal(ks[1], (DEC_BATCH, DEC_SEQ, D_MODEL), f32),
        "p_prompt": jax.random.normal(ks[2], (DEPTH, BATCH, SEQ, PLE_DIM), f32),
        "p_sample": jax.random.normal(ks[3], (DEPTH, DEC_BATCH, DEC_SEQ, PLE_DIM), f32),
        "g_pre": gain(ks[4], (DEPTH, D_MODEL)),
        "g_post": gain(ks[5], (DEPTH, D_MODEL)),
        "w_ple": nrm(ks[6], (DEPTH, PLE_DIM, D_MODEL), PLE_DIM),
        "w_ple_gate": nrm(ks[7], (DEPTH, D_MODEL, D_MODEL), D_MODEL),
        "w_in_e": nrm(ks[8], (N_EVEN, D_MODEL, EVEN_IN), D_MODEL),
        "rpb": 0.1 * jax.random.normal(ks[9], (N_EVEN, NA_HEADS, 2 * NA_WIN_ROWS - 1, 2 * NA_WIN_COLS - 1), f32),
        "dw_w": nrm(ks[10], (N_EVEN, CONV_WIDTH, CONV_CH), CONV_WIDTH),
        "dw_b": 0.02 * jax.random.normal(ks[11], (N_EVEN, CONV_CH), f32),
        "cln_g": gain(ks[12], (N_EVEN, CONV_CH)),
        "cln_b": 0.02 * jax.random.normal(ks[13], (N_EVEN, CONV_CH), f32),
        "w_out_e": nrm(ks[14], (N_EVEN, NA_W + CONV_CH, D_MODEL), NA_W + CONV_CH),
        "w_in_o": nrm(ks[15], (N_ODD, D_MODEL, ODD_IN), D_MODEL),
        "q_norm_g": gain(ks[16], (N_ODD, Q_LORA)),
        "kv_norm_g": gain(ks[17], (N_ODD, KV_LORA)),
        "w_uq": nrm(ks[18], (N_ODD, Q_LORA, MLA_HEADS * (MLA_NOPE + MLA_ROPE)), Q_LORA),
        "w_ukv": nrm(ks[19], (N_ODD, KV_LORA, MLA_HEADS * (MLA_NOPE + MLA_V)), KV_LORA),
        "w_out_o": nrm(ks[20], (N_ODD, MLA_W + FNET_W, D_MODEL), MLA_W + FNET_W),
    }


def reference(x_prompt, x_sample, p_prompt, p_sample, g_pre, g_post, w_ple, w_ple_gate,
              w_in_e, rpb, dw_w, dw_b, cln_g, cln_b, w_out_e,
              w_in_o, q_norm_g, kv_norm_g, w_uq, w_ukv, w_out_o):
    y_prompt = _trunk(x_prompt, p_prompt, g_pre, g_post, w_ple, w_ple_gate,
                      w_in_e, rpb, dw_w, dw_b, cln_g, cln_b, w_out_e,
                      w_in_o, q_norm_g, kv_norm_g, w_uq, w_ukv, w_out_o)
    y_sample = _trunk(x_sample, p_sample, g_pre, g_post, w_ple, w_ple_gate,
                      w_in_e, rpb, dw_w, dw_b, cln_g, cln_b, w_out_e,
                      w_in_o, q_norm_g, kv_norm_g, w_uq, w_ukv, w_out_o)
    return (y_prompt, y_sample)
```

```cpp
#include <hip/hip_runtime.h>
#include <hip/hip_cooperative_groups.h>
#include <cstdio>
#include <cmath>
namespace cg = cooperative_groups;

#ifndef MK_COOP
#define MK_COOP 1
#endif

typedef unsigned short bf16_t;
typedef short bf16x8 __attribute__((ext_vector_type(8)));
typedef float f32x16 __attribute__((ext_vector_type(16)));
typedef float f32x4 __attribute__((ext_vector_type(4)));
typedef __bf16 bf16v2 __attribute__((ext_vector_type(2)));
typedef float f32v2 __attribute__((ext_vector_type(2)));
#define DI __device__ __forceinline__
#define MFMA32(a, b, c) __builtin_amdgcn_mfma_f32_32x32x16_bf16((a), (b), (c), 0, 0, 0)
#define MFMA16(a, b, c) __builtin_amdgcn_mfma_f32_16x16x32_bf16((a), (b), (c), 0, 0, 0)

constexpr int TOK = 65536;
constexpr float EPS = 1e-6f;
constexpr float LOG2E = 1.4426950408889634f;
constexpr int NTHR = 256;

constexpr size_t MBy = 1u << 20;
constexpr size_t OFF_WINE = 0;
constexpr size_t OFF_WOUTE = 7 * MBy;
constexpr size_t OFF_WOUTO = 9 * MBy;
constexpr size_t OFF_WG0 = 11 * MBy;
constexpr size_t OFF_WG1 = 13 * MBy;
constexpr size_t OFF_WE0 = 15 * MBy;
constexpr size_t OFF_WE1 = 15 * MBy + 512 * 1024;
constexpr size_t OFF_WINO = 16 * MBy;
constexpr size_t OFF_WUQ = 21 * MBy;
constexpr size_t OFF_WUKV = 21 * MBy + 512 * 1024;
constexpr size_t OFF_ROPEC = 22 * MBy;
constexpr size_t OFF_ROPES = 22 * MBy + 512 * 1024;
constexpr size_t OFF_RSIN = 23 * MBy;
constexpr size_t OFF_SS = 24 * MBy;
constexpr size_t OFF_SSX = 28 * MBy;
constexpr size_t OFF_SSQ = 32 * MBy;
constexpr size_t OFF_SSKV = 33 * MBy;
constexpr size_t OFF_CAT = 34 * MBy;
constexpr size_t OFF_X2B = 162 * MBy;
constexpr size_t OFF_L = 290 * MBy;
constexpr size_t ME = 1u << 20;
constexpr size_t L0_Q = 0, L0_K = 32 * ME, L0_VT = 64 * ME, L0_GA = 96 * ME, L0_UA = 128 * ME, L0_UB = 160 * ME, L0_GB = 192 * ME;
constexpr size_t L0_OB = 0, L0_X1B = 128 * ME;
constexpr size_t L1_YT = 0, L1_QM = 64 * ME, L1_KN = 112 * ME, L1_VT = 144 * ME, L1_GC = 176 * ME, L1_GD = 208 * ME,
                 L1_CQ = 240 * ME, L1_CKV = 256 * ME, L1_KR = 264 * ME;
constexpr size_t L1_OB = 0, L1_X1B = 64 * ME;

struct Params {
  const float* x0; const float* x1; const float* p0; const float* p1;
  float* y0; float* y1;
  const float* g_pre; const float* g_post; const float* w_ple; const float* w_ple_gate;
  const float* w_in_e; const float* rpb; const float* dw_w; const float* dw_b; const float* cln_g; const float* cln_b;
  const float* w_out_e; const float* w_in_o; const float* q_norm_g; const float* kv_norm_g;
  const float* w_uq; const float* w_ukv; const float* w_out_o;
  char* ws;
  float inv_freq[16];
};

DI unsigned pk2(float a, float b) { f32v2 v = {a, b}; return __builtin_bit_cast(unsigned, __builtin_convertvector(v, bf16v2)); }
DI float bflo(unsigned u) { return __uint_as_float(u << 16); }
DI float bfhi(unsigned u) { return __uint_as_float(u & 0xffff0000u); }
DI float sigmoidf_(float v) { return 1.f / (1.f + __expf(-v)); }
DI float siluf_(float v) { return v / (1.f + __expf(-v)); }
DI void store4(bf16_t* p, float a, float b, float c, float d) { *(uint2*)p = make_uint2(pk2(a, b), pk2(c, d)); }
DI int otid() { int t = threadIdx.x; asm volatile("" : "+v"(t)); return t; }
DI int obid() { int t = blockIdx.x; asm volatile("" : "+s"(t)); return t; }
DI float wave_sum(float s) {
#pragma unroll
  for (int o = 32; o; o >>= 1) s += __shfl_xor(s, o);
  return s;
}

constexpr int LDT = 72;
constexpr int TILE_E = 128 * LDT;
constexpr int SMEM_E = 4 * TILE_E;

struct LoadBf16 {
  const bf16_t* base; int ld;
  DI void pos(int i, int tid, int& row, int& kc) const { int c = tid + 256 * i; row = c >> 3; kc = c & 7; }
  DI void load(int kt, uint4 (&r)[4], int tid) const {
#pragma unroll
    for (int i = 0; i < 4; i++) { int row, kc; pos(i, tid, row, kc); r[i] = *(const uint4*)(base + (size_t)row * ld + kt * 64 + kc * 8); }
  }
};
struct LoadF32 {
  const float* base; int ld;
  DI void pos(int i, int tid, int& row, int& kc) const { int c = tid + 256 * i; row = c >> 3; kc = c & 7; }
  DI void load(int kt, uint4 (&r)[4], int tid) const {
#pragma unroll
    for (int i = 0; i < 4; i++) {
      int row, kc; pos(i, tid, row, kc);
      const float* s = base + (size_t)row * ld + kt * 64 + kc * 8;
      float4 a = *(const float4*)s, b = *(const float4*)(s + 4);
      r[i] = make_uint4(pk2(a.x, a.y), pk2(a.z, a.w), pk2(b.x, b.y), pk2(b.z, b.w));
    }
  }
};
struct LoadYt {
  const bf16_t* base; int S;
  DI void pos(int i, int tid, int& row, int& kc) const { int c = tid + 256 * i; row = c >> 3; kc = c & 7; }
  DI void load(int kt, uint4 (&r)[4], int tid) const {
#pragma unroll
    for (int i = 0; i < 4; i++) {
      int row, kc; pos(i, tid, row, kc);
      r[i] = *(const uint4*)(base + (size_t)(row + (kc >> 2) * 512) * S + kt * 32 + (kc & 3) * 8);
    }
  }
};
struct LoadDft {
  int ks0, S; float invS; float cd[2], sd[2];
  DI void init(int tid) {
#pragma unroll
    for (int i2 = 0; i2 < 2; i2++) {
      int row = (tid + 256 * i2) >> 2; float f = (float)(ks0 + row) * invS;
      cd[i2] = __builtin_amdgcn_cosf(f); sd[i2] = __builtin_amdgcn_sinf(f);
    }
  }
  DI void pos(int i, int tid, int& row, int& kc) const { int q = tid + 256 * (i >> 1); row = q >> 2; kc = (q & 3) + 4 * (i & 1); }
  DI void load(int kt, uint4 (&r)[4], int tid) const {
#pragma unroll
    for (int i2 = 0; i2 < 2; i2++) {
      int q = tid + 256 * i2; int row = q >> 2, seg = q & 3;
      int ks = ks0 + row; int sst = kt * 32 + seg * 8;
      int idx = (ks * sst) & (S - 1);
      float f = (float)idx * invS;
      float cc[8], sn[8];
      cc[0] = __builtin_amdgcn_cosf(f); sn[0] = __builtin_amdgcn_sinf(f);
#pragma unroll
      for (int j = 1; j < 8; j++) { cc[j] = cc[j - 1] * cd[i2] - sn[j - 1] * sd[i2]; sn[j] = sn[j - 1] * cd[i2] + cc[j - 1] * sd[i2]; }
      r[2 * i2] = make_uint4(pk2(cc[0], cc[1]), pk2(cc[2], cc[3]), pk2(cc[4], cc[5]), pk2(cc[6], cc[7]));
      r[2 * i2 + 1] = make_uint4(pk2(-sn[0], -sn[1]), pk2(-sn[2], -sn[3]), pk2(-sn[4], -sn[5]), pk2(-sn[6], -sn[7]));
    }
  }
};

template <class LA, class LB>
DI void gemm_core(const LA& la, const LB& lb, const int nk, bf16_t* smem, f32x16 (&acc)[2][2], const bool swap) {
  const int tid = otid();
  const int lane = tid & 63, w = tid >> 6, wm = w >> 1, wn = w & 1, l32 = lane & 31, h = lane >> 5;
  uint4 ra[4], rb[4];
  la.load(0, ra, tid); lb.load(0, rb, tid);
  {
    bf16_t* sA = smem; bf16_t* sB = smem + TILE_E;
#pragma unroll
    for (int i = 0; i < 4; i++) {
      int row, kc;
      la.pos(i, tid, row, kc); *(uint4*)(sA + row * LDT + kc * 8) = ra[i];
      lb.pos(i, tid, row, kc); *(uint4*)(sB + row * LDT + kc * 8) = rb[i];
    }
  }
  __syncthreads();
  const int moff = (wm * 64 + l32) * LDT + h * 8;
  const int noff = (wn * 64 + l32) * LDT + h * 8;
  for (int kt = 0; kt < nk; kt++) {
    const int cur = kt & 1;
    if (kt + 1 < nk) { la.load(kt + 1, ra, tid); lb.load(kt + 1, rb, tid); }
    const bf16_t* sA = smem + cur * 2 * TILE_E; const bf16_t* sB = sA + TILE_E;
    const bf16_t* sM = swap ? sB : sA; const bf16_t* sN = swap ? sA : sB;
#pragma unroll
    for (int kk = 0; kk < 4; kk++) {
      bf16x8 fm0 = *(const bf16x8*)(sM + moff + kk * 16);
      bf16x8 fm1 = *(const bf16x8*)(sM + moff + 32 * LDT + kk * 16);
      bf16x8 fn0 = *(const bf16x8*)(sN + noff + kk * 16);
      bf16x8 fn1 = *(const bf16x8*)(sN + noff + 32 * LDT + kk * 16);
      acc[0][0] = MFMA32(fm0, fn0, acc[0][0]); acc[0][1] = MFMA32(fm0, fn1, acc[0][1]);
      acc[1][0] = MFMA32(fm1, fn0, acc[1][0]); acc[1][1] = MFMA32(fm1, fn1, acc[1][1]);
    }
    if (kt + 1 < nk) {
      bf16_t* dA = smem + (cur ^ 1) * 2 * TILE_E; bf16_t* dB = dA + TILE_E;
#pragma unroll
      for (int i = 0; i < 4; i++) {
        int row, kc;
        la.pos(i, tid, row, kc); *(uint4*)(dA + row * LDT + kc * 8) = ra[i];
        lb.pos(i, tid, row, kc); *(uint4*)(dB + row * LDT + kc * 8) = rb[i];
      }
    }
    __syncthreads();
  }
}

#define ZERO_ACC(a) { _Pragma("unroll") for (int i_ = 0; i_ < 2; i_++) _Pragma("unroll") for (int j_ = 0; j_ < 2; j_++) _Pragma("unroll") for (int r_ = 0; r_ < 16; r_++) a[i_][j_][r_] = 0.f; }
#define WAVE_IDS const int tid = otid(); const int bid = obid(); (void)bid; const int lane = tid & 63, w = tid >> 6, wm = w >> 1, wn = w & 1, l32 = lane & 31, h = lane >> 5; (void)lane; (void)wm; (void)wn; (void)l32; (void)h;

template <class F>
DI void cvt_task(bf16_t* dst, int N, int K, F f, int gt, int gs) {
  const int nu = N * (K >> 3);
  for (int u = gt; u < nu; u += gs) {
    int n = u % N, kc = u / N; float v[8];
#pragma unroll
    for (int j = 0; j < 8; j++) v[j] = f(kc * 8 + j, n);
    *(uint4*)(dst + (size_t)n * K + kc * 8) = make_uint4(pk2(v[0], v[1]), pk2(v[2], v[3]), pk2(v[4], v[5]), pk2(v[6], v[7]));
  }
}

DI void ph_prelude(const Params& P) {
  const int tid0 = otid();
  const int gt = obid() * NTHR + tid0, gs = gridDim.x * NTHR;
  char* ws = P.ws;
  { const float* w = P.w_in_e; const float* gp = P.g_pre;
    cvt_task((bf16_t*)(ws + OFF_WINE), 3584, 1024, [=](int k, int n) { return w[(size_t)k * 3584 + n] * gp[k] * (n < 512 ? 0.125f * LOG2E : 1.f); }, gt, gs); }
  { const float* w = P.w_out_e; cvt_task((bf16_t*)(ws + OFF_WOUTE), 1024, 1024, [=](int k, int n) { return w[(size_t)k * 1024 + n]; }, gt, gs); }
  { const float* w = P.w_out_o; cvt_task((bf16_t*)(ws + OFF_WOUTO), 1024, 1024, [=](int k, int n) { return w[(size_t)k * 1024 + n]; }, gt, gs); }
  { const float* w = P.w_ple_gate; cvt_task((bf16_t*)(ws + OFF_WG0), 1024, 1024, [=](int k, int n) { return w[(size_t)k * 1024 + n]; }, gt, gs); }
  { const float* w = P.w_ple_gate + 1024 * 1024; cvt_task((bf16_t*)(ws + OFF_WG1), 1024, 1024, [=](int k, int n) { return w[(size_t)k * 1024 + n]; }, gt, gs); }
  { const float* w = P.w_ple; cvt_task((bf16_t*)(ws + OFF_WE0), 1024, 256, [=](int k, int n) { return w[(size_t)k * 1024 + n]; }, gt, gs); }
  { const float* w = P.w_ple + 256 * 1024; cvt_task((bf16_t*)(ws + OFF_WE1), 1024, 256, [=](int k, int n) { return w[(size_t)k * 1024 + n]; }, gt, gs); }
  {
    const float* w = P.w_in_o; const float* gp = P.g_pre + 1024;
    cvt_task((bf16_t*)(ws + OFF_WINO), 1024, 1024, [=](int k, int n) {
      int col; if (n < 384) col = n; else if (n < 512) { col = (n < 416) ? n : -1; } else col = 416 + (n - 512);
      return col < 0 ? 0.f : w[(size_t)k * 1952 + col] * gp[k]; }, gt, gs);
    cvt_task((bf16_t*)(ws + OFF_WINO) + (size_t)2048 * 1024, 512, 1024, [=](int k, int n) { return w[(size_t)k * 1952 + 1440 + n] * gp[k]; }, gt, gs);
    bf16_t* dst = (bf16_t*)(ws + OFF_WINO) + (size_t)1024 * 1024;
    for (int u = gt; u < 1024 * 128; u += gs) {
      int nn = u & 1023, kcb = u >> 10; int part = nn >> 9, ch = nn & 511, gi = ch >> 7, kc_ = ch & 127;
      float a[8];
#pragma unroll
      for (int j = 0; j < 8; j++) a[j] = 0.f;
      const float* wp = w + 928 + gi * 128 + (size_t)(kcb * 8) * 1952;
      for (int c = 0; c < 128; c++) {
        float f = (float)((kc_ * c) & 127) * (1.f / 128.f);
        float tr = part ? __builtin_amdgcn_sinf(f) : __builtin_amdgcn_cosf(f);
#pragma unroll
        for (int j = 0; j < 8; j++) a[j] += wp[(size_t)j * 1952 + c] * tr;
      }
#pragma unroll
      for (int j = 0; j < 8; j++) a[j] *= gp[kcb * 8 + j];
      *(uint4*)(dst + (size_t)nn * 1024 + kcb * 8) = make_uint4(pk2(a[0], a[1]), pk2(a[2], a[3]), pk2(a[4], a[5]), pk2(a[6], a[7]));
    }
  }
  { const float* w = P.w_uq; const float* gq = P.q_norm_g; const float sc = 0.10206207261596577f * LOG2E;
    cvt_task((bf16_t*)(ws + OFF_WUQ), 768, 256, [=](int k, int n) { return w[(size_t)k * 768 + n] * gq[k] * sc; }, gt, gs); }
  { const float* w = P.w_ukv; const float* gk = P.kv_norm_g;
    cvt_task((bf16_t*)(ws + OFF_WUKV), 1024, 128, [=](int k, int n) {
      int col = (n < 512) ? ((n >> 6) * 128 + (n & 63)) : (((n - 512) >> 6) * 128 + 64 + (n & 63));
      return w[(size_t)k * 1024 + col] * gk[k]; }, gt, gs); }
  { float* rc = (float*)(ws + OFF_ROPEC); float* rsn = (float*)(ws + OFF_ROPES);
    for (int u = gt; u < 8192 * 16; u += gs) {
      int pos = u >> 4, i = u & 15;
      float fr = P.inv_freq[0];
#pragma unroll
      for (int k = 1; k < 16; k++) fr = (i == k) ? P.inv_freq[k] : fr;
      float ang = (float)pos * fr;
      double t = (double)ang * 0.15915494309189535; t -= floor(t);
      float f = (float)t;
      rc[u] = __builtin_amdgcn_cosf(f); rsn[u] = __builtin_amdgcn_sinf(f);
    } }
  { float* rs = (float*)(ws + OFF_RSIN);
    const int wid = gt >> 6, nw = gs >> 6, lane = tid0 & 63;
    for (int t = wid; t < 2 * TOK; t += nw) {
      const float* xr = ((t >> 16) ? P.x1 : P.x0) + (size_t)(t & (TOK - 1)) * 1024;
      float s = 0.f;
#pragma unroll
      for (int k = 0; k < 4; k++) { float4 v = *(const float4*)(xr + (k * 64 + lane) * 4); s += v.x * v.x + v.y * v.y + v.z * v.z + v.w * v.w; }
      s = wave_sum(s);
      if (lane == 0) rs[t] = rsqrtf(s * (1.f / 1024.f) + EPS);
    } }
}

DI void ph_in_e(const Params& P, int g, bf16_t* smem, float* s_rs) {
  WAVE_IDS
  const int S = g ? 4096 : 8192;
  const float* x = g ? P.x1 : P.x0;
  const float* rs_in = (const float*)(P.ws + OFF_RSIN) + g * TOK;
  const bf16_t* W = (const bf16_t*)(P.ws + OFF_WINE);
  bf16_t* L = (bf16_t*)(P.ws + OFF_L);
  for (int t = bid; t < 512 * 28; t += gridDim.x) {
    const int mt = t / 28, nt = t % 28; const int m0 = mt * 128, n0 = nt * 128; const int split = nt >> 2, cin = (nt & 3) * 128;
    __syncthreads();
    if (tid < 128) s_rs[tid] = rs_in[m0 + tid];
    f32x16 acc[2][2]; ZERO_ACC(acc)
    LoadF32 la{x + (size_t)m0 * 1024, 1024}; LoadBf16 lb{W + (size_t)n0 * 1024, 1024};
    const bool swap = (split != 2);
    gemm_core(la, lb, 16, smem, acc, swap);
    if (swap) {
      bf16_t* dst = L + (size_t)split * 32 * ME;
#pragma unroll
      for (int j = 0; j < 2; j++) {
        const int tl = wn * 64 + j * 32 + l32; const float rs = s_rs[tl];
        bf16_t* drow = dst + (size_t)(m0 + tl) * 512 + cin;
#pragma unroll
        for (int i = 0; i < 2; i++)
#pragma unroll
          for (int rq = 0; rq < 4; rq++) {
            const int c = wm * 64 + i * 32 + 8 * rq + 4 * h;
            store4(drow + c, acc[i][j][4 * rq] * rs, acc[i][j][4 * rq + 1] * rs, acc[i][j][4 * rq + 2] * rs, acc[i][j][4 * rq + 3] * rs);
          }
      }
    } else {
      bf16_t* Vt = L + L0_VT;
#pragma unroll
      for (int j = 0; j < 2; j++) {
        const int c = cin + wn * 64 + j * 32 + l32; const int hh = c >> 6, d = c & 63;
#pragma unroll
        for (int i = 0; i < 2; i++)
#pragma unroll
          for (int rq = 0; rq < 4; rq++) {
            const int tl = wm * 64 + i * 32 + 8 * rq + 4 * h; const int tg = m0 + tl; const int b = tg / S, s = tg % S;
            store4(Vt + ((size_t)(b * 8 + hh) * 64 + d) * S + s, acc[i][j][4 * rq] * s_rs[tl], acc[i][j][4 * rq + 1] * s_rs[tl + 1],
                   acc[i][j][4 * rq + 2] * s_rs[tl + 2], acc[i][j][4 * rq + 3] * s_rs[tl + 3]);
          }
      }
    }
  }
}

DI void na_item(const Params& P, int g, int item, bf16_t* smem) {
  const int tid = otid(), lane = tid & 63, w = tid >> 6, q = lane & 15, gq = lane >> 4;
  const int S = g ? 4096 : 8192; const int rows = S >> 6;
  const int hh = item & 7; const int br = item >> 3; const int r = br % rows, b = br / rows;
  float* s_rpb = (float*)smem;
  __syncthreads();
  for (int i = tid; i < 465; i += NTHR) s_rpb[i] = P.rpb[hh * 465 + i] * LOG2E;
  __syncthreads();
  const bf16_t* L = (const bf16_t*)(P.ws + OFF_L);
  const bf16_t* Qb = L + L0_Q; const bf16_t* Kb = L + L0_K; const bf16_t* Vt = L + L0_VT; const bf16_t* Ga = L + L0_GA;
  bf16_t* cat = (bf16_t*)(P.ws + OFF_CAT);
  int rs_ = r - 4; rs_ = rs_ < 0 ? 0 : rs_; rs_ = rs_ > rows - 8 ? rows - 8 : rs_;
  const int cb = (w == 0) ? 0 : (w == 1) ? 8 : (w == 2) ? 24 : 32;
  const int c = 16 * w + q; int cs = c - 8; cs = cs < 0 ? 0 : cs; cs = cs > 48 ? 48 : cs;
  const size_t tb = (size_t)b * S;
  const bf16_t* qp = Qb + (tb + r * 64 + c) * 512 + hh * 64 + gq * 8;
  const bf16x8 qf0 = *(const bf16x8*)qp, qf1 = *(const bf16x8*)(qp + 32);
  f32x4 sc[8][2];
#pragma unroll
  for (int kr = 0; kr < 8; kr++)
#pragma unroll
    for (int T = 0; T < 2; T++) {
      const bf16_t* kp = Kb + (tb + (rs_ + kr) * 64 + cb + 16 * T + q) * 512 + hh * 64 + gq * 8;
      bf16x8 k0 = *(const bf16x8*)kp, k1 = *(const bf16x8*)(kp + 32);
      f32x4 a = {0.f, 0.f, 0.f, 0.f};
      a = MFMA16(k0, qf0, a); a = MFMA16(k1, qf1, a);
      sc[kr][T] = a;
    }
  float mx = -1e30f;
#pragma unroll
  for (int kr = 0; kr < 8; kr++)
#pragma unroll
    for (int T = 0; T < 2; T++)
#pragma unroll
      for (int i = 0; i < 4; i++) {
        const int kc = cb + 16 * T + 4 * gq + i;
        const bool valid = (kc >= cs) && (kc < cs + 16);
        const int dr = rs_ + kr - r + 7, dc = kc - c + 15;
        const float bias = s_rpb[valid ? dr * 31 + dc : 0];
        const float v = valid ? sc[kr][T][i] + bias : -1e30f;
        sc[kr][T][i] = v; mx = fmaxf(mx, v);
      }
  mx = fmaxf(mx, __shfl_xor(mx, 16)); mx = fmaxf(mx, __shfl_xor(mx, 32));
  float sum = 0.f;
#pragma unroll
  for (int kr = 0; kr < 8; kr++)
#pragma unroll
    for (int T = 0; T < 2; T++)
#pragma unroll
      for (int i = 0; i < 4; i++) { float p = exp2f(sc[kr][T][i] - mx); sc[kr][T][i] = p; sum += p; }
  sum += __shfl_xor(sum, 16); sum += __shfl_xor(sum, 32);
  f32x4 o[4];
#pragma unroll
  for (int m = 0; m < 4; m++) o[m] = f32x4{0.f, 0.f, 0.f, 0.f};
#pragma unroll
  for (int kr = 0; kr < 8; kr++) {
    uint4 pu = make_uint4(pk2(sc[kr][0][0], sc[kr][0][1]), pk2(sc[kr][0][2], sc[kr][0][3]), pk2(sc[kr][1][0], sc[kr][1][1]), pk2(sc[kr][1][2], sc[kr][1][3]));
    const bf16x8 pb = __builtin_bit_cast(bf16x8, pu);
#pragma unroll
    for (int m = 0; m < 4; m++) {
      const bf16_t* vp = Vt + ((size_t)(b * 8 + hh) * 64 + m * 16 + q) * S + (rs_ + kr) * 64 + cb + 4 * gq;
      uint2 lo = *(const uint2*)vp, hi = *(const uint2*)(vp + 16);
      const bf16x8 av = __builtin_bit_cast(bf16x8, make_uint4(lo.x, lo.y, hi.x, hi.y));
      o[m] = MFMA16(av, pb, o[m]);
    }
  }
  const float inv = 1.f / sum;
  const size_t tq = tb + r * 64 + c;
#pragma unroll
  for (int m = 0; m < 4; m++) {
    const int dv = hh * 64 + m * 16 + 4 * gq;
    uint2 gu = *(const uint2*)(Ga + tq * 512 + dv);
    store4(cat + tq * 1024 + dv, o[m][0] * inv * siluf_(bflo(gu.x)), o[m][1] * inv * siluf_(bfhi(gu.x)),
           o[m][2] * inv * siluf_(bflo(gu.y)), o[m][3] * inv * siluf_(bfhi(gu.y)));
  }
}

DI void conv_item(const Params& P, int g, int item, bf16_t* smem) {
  const int tid = otid(), lane = tid & 63, w = tid >> 6;
  const int S = g ? 4096 : 8192;
  const int t0 = item * 32; const int b = t0 / S, s0 = t0 % S;
  const bf16_t* L = (const bf16_t*)(P.ws + OFF_L);
  const bf16_t* Ua = L + L0_UA; const bf16_t* Ub = L + L0_UB; const bf16_t* Gb = L + L0_GB;
  bf16_t* cat = (bf16_t*)(P.ws + OFF_CAT);
  const size_t tb = (size_t)b * S;
  __syncthreads();
  for (int c = tid; c < 62 * 64; c += NTHR) {
    const int row = c >> 6, cc = c & 63; const int s = s0 - 15 + row;
    uint4 o = make_uint4(0, 0, 0, 0);
    if (s >= 0 && s < S) {
      uint4 a = *(const uint4*)(Ua + (tb + s) * 512 + cc * 8), bb = *(const uint4*)(Ub + (tb + s) * 512 + cc * 8);
      o.x = pk2(bflo(a.x) * sigmoidf_(bflo(bb.x)), bfhi(a.x) * sigmoidf_(bfhi(bb.x)));
      o.y = pk2(bflo(a.y) * sigmoidf_(bflo(bb.y)), bfhi(a.y) * sigmoidf_(bfhi(bb.y)));
      o.z = pk2(bflo(a.z) * sigmoidf_(bflo(bb.z)), bfhi(a.z) * sigmoidf_(bfhi(bb.z)));
      o.w = pk2(bflo(a.w) * sigmoidf_(bflo(bb.w)), bfhi(a.w) * sigmoidf_(bfhi(bb.w)));
    }
    *(uint4*)(smem + row * 512 + cc * 8) = o;
  }
  __syncthreads();
  {
    float wx[31], wy[31];
#pragma unroll
    for (int j = 0; j < 31; j++) { float2 v = *(const float2*)(P.dw_w + j * 512 + 2 * tid); wx[j] = v.x; wy[j] = v.y; }
    const float2 bias = *(const float2*)(P.dw_b + 2 * tid);
    unsigned* su = (unsigned*)smem;
    for (int tg = 0; tg < 4; tg++) {
      float ax[8], ay[8];
#pragma unroll
      for (int k = 0; k < 8; k++) { ax[k] = bias.x; ay[k] = bias.y; }
#pragma unroll
      for (int rr = 0; rr < 38; rr++) {
        const unsigned u = su[(tg * 8 + rr) * 256 + tid];
        const float vx = bflo(u), vy = bfhi(u);
#pragma unroll
        for (int k = 0; k < 8; k++) {
          const int j = rr - k;
          if (j >= 0 && j <= 30) { ax[k] += vx * wx[j]; ay[k] += vy * wy[j]; }
        }
      }
#pragma unroll
      for (int k = 0; k < 8; k++) su[(tg * 8 + k) * 256 + tid] = pk2(ax[k], ay[k]);
    }
  }
  __syncthreads();
  for (int k = 0; k < 8; k++) {
    const int tl = w * 8 + k;
    uint4 u = *(const uint4*)(smem + tl * 512 + lane * 8);
    float v[8] = {bflo(u.x), bfhi(u.x), bflo(u.y), bfhi(u.y), bflo(u.z), bfhi(u.z), bflo(u.w), bfhi(u.w)};
    float s1 = 0.f, s2 = 0.f;
#pragma unroll
    for (int j = 0; j < 8; j++) { s1 += v[j]; s2 += v[j] * v[j]; }
    s1 = wave_sum(s1); s2 = wave_sum(s2);
    const float mu = s1 * (1.f / 512.f); float var = s2 * (1.f / 512.f) - mu * mu; var = var < 0.f ? 0.f : var;
    const float rstd = rsqrtf(var + EPS);
    const size_t tq = tb + s0 + tl;
    const uint4 gu = *(const uint4*)(Gb + tq * 512 + lane * 8);
    const float gg[8] = {bflo(gu.x), bfhi(gu.x), bflo(gu.y), bfhi(gu.y), bflo(gu.z), bfhi(gu.z), bflo(gu.w), bfhi(gu.w)};
    const float4 lg0 = *(const float4*)(P.cln_g + lane * 8), lg1 = *(const float4*)(P.cln_g + lane * 8 + 4);
    const float4 lb0 = *(const float4*)(P.cln_b + lane * 8), lb1 = *(const float4*)(P.cln_b + lane * 8 + 4);
    const float lg[8] = {lg0.x, lg0.y, lg0.z, lg0.w, lg1.x, lg1.y, lg1.z, lg1.w};
    const float lb[8] = {lb0.x, lb0.y, lb0.z, lb0.w, lb1.x, lb1.y, lb1.z, lb1.w};
    float ov[8];
#pragma unroll
    for (int j = 0; j < 8; j++) { float y = (v[j] - mu) * rstd * lg[j] + lb[j]; ov[j] = siluf_(y) * siluf_(gg[j]); }
    *(uint4*)(cat + tq * 1024 + 512 + lane * 8) = make_uint4(pk2(ov[0], ov[1]), pk2(ov[2], ov[3]), pk2(ov[4], ov[5]), pk2(ov[6], ov[7]));
  }
}

DI void ph_mix_e(const Params& P, int g, bf16_t* smem) {
  const int nconv = TOK / 32, nna = 8192;
  for (int it = obid(); it < nconv + nna; it += gridDim.x) {
    if (it < nconv) conv_item(P, g, it, smem); else na_item(P, g, it - nconv, smem);
  }
}

DI void ph_out(const Params& P, int layer, bf16_t* smem) {
  WAVE_IDS
  const bf16_t* cat = (const bf16_t*)(P.ws + OFF_CAT);
  const bf16_t* W = (const bf16_t*)(P.ws + (layer ? OFF_WOUTO : OFF_WOUTE));
  bf16_t* ob = (bf16_t*)(P.ws + OFF_L) + (layer ? L1_OB : L0_OB);
  float* ss = (float*)(P.ws + OFF_SS);
  for (int t = bid; t < 512 * 8; t += gridDim.x) {
    const int mt = t >> 3, nt = t & 7; const int m0 = mt * 128, n0 = nt * 128;
    __syncthreads();
    f32x16 acc[2][2]; ZERO_ACC(acc)
    LoadBf16 la{cat + (size_t)m0 * 1024, 1024}; LoadBf16 lb{W + (size_t)n0 * 1024, 1024};
    gemm_core(la, lb, 16, smem, acc, true);
#pragma unroll
    for (int j = 0; j < 2; j++) {
      const int tl = wn * 64 + j * 32 + l32; const size_t tg = (size_t)m0 + tl;
      float sq = 0.f;
#pragma unroll
      for (int i = 0; i < 2; i++)
#pragma unroll
        for (int rq = 0; rq < 4; rq++) {
          const int c = n0 + wm * 64 + i * 32 + 8 * rq + 4 * h;
          const float a0 = acc[i][j][4 * rq], a1 = acc[i][j][4 * rq + 1], a2 = acc[i][j][4 * rq + 2], a3 = acc[i][j][4 * rq + 3];
          sq += a0 * a0 + a1 * a1 + a2 * a2 + a3 * a3;
          store4(ob + tg * 1024 + c, a0, a1, a2, a3);
        }
      sq += __shfl_xor(sq, 32);
      if (h == 0) ss[tg * 16 + nt * 2 + wm] = sq;
    }
  }
}

DI void ph_resid(const Params& P, int g, int layer) {
  const int tid0 = otid(); const int lane = tid0 & 63;
  const int wid = (obid() * NTHR + tid0) >> 6, nw = (gridDim.x * NTHR) >> 6;
  const float* xs = layer ? (g ? P.y1 : P.y0) : (g ? P.x1 : P.x0);
  float* y = g ? P.y1 : P.y0;
  const bf16_t* ob = (const bf16_t*)(P.ws + OFF_L) + (layer ? L1_OB : L0_OB);
  bf16_t* x1b = (bf16_t*)(P.ws + OFF_L) + (layer ? L1_X1B : L0_X1B);
  const float* ss = (const float*)(P.ws + OFF_SS);
  const float* gp = P.g_post + layer * 1024;
  for (int t = wid; t < TOK; t += nw) {
    float s = (lane < 16) ? ss[(size_t)t * 16 + lane] : 0.f;
    s = wave_sum(s);
    const float rs = rsqrtf(s * (1.f / 1024.f) + EPS);
#pragma unroll
    for (int k = 0; k < 4; k++) {
      const int f = (k * 64 + lane) * 4;
      const float4 xv = *(const float4*)(xs + (size_t)t * 1024 + f);
      const uint2 ou = *(const uint2*)(ob + (size_t)t * 1024 + f);
      const float4 gv = *(const float4*)(gp + f);
      float4 r;
      r.x = xv.x + bflo(ou.x) * rs * gv.x; r.y = xv.y + bfhi(ou.x) * rs * gv.y;
      r.z = xv.z + bflo(ou.y) * rs * gv.z; r.w = xv.w + bfhi(ou.y) * rs * gv.w;
      *(float4*)(y + (size_t)t * 1024 + f) = r;
      store4(x1b + (size_t)t * 1024 + f, r.x, r.y, r.z, r.w);
    }
  }
}

DI void ph_ple(const Params& P, int g, int layer, bf16_t* smem) {
  WAVE_IDS
  const bf16_t* x1b = (const bf16_t*)(P.ws + OFF_L) + (layer ? L1_X1B : L0_X1B);
  const bf16_t* Wg = (const bf16_t*)(P.ws + (layer ? OFF_WG1 : OFF_WG0));
  const bf16_t* We = (const bf16_t*)(P.ws + (layer ? OFF_WE1 : OFF_WE0));
  const float* pp = (g ? P.p1 : P.p0) + (size_t)layer * TOK * 256;
  float* y = g ? P.y1 : P.y0;
  bf16_t* x2b = (bf16_t*)(P.ws + OFF_X2B);
  float* ssx = (float*)(P.ws + OFF_SSX);
  for (int t = bid; t < 512 * 8; t += gridDim.x) {
    const int mt = t >> 3, nt = t & 7; const int m0 = mt * 128, n0 = nt * 128;
    __syncthreads();
    f32x16 acc[2][2]; ZERO_ACC(acc)
    { LoadBf16 la{x1b + (size_t)m0 * 1024, 1024}; LoadBf16 lb{Wg + (size_t)n0 * 1024, 1024}; gemm_core(la, lb, 16, smem, acc, true); }
#pragma unroll
    for (int i = 0; i < 2; i++)
#pragma unroll
      for (int j = 0; j < 2; j++)
#pragma unroll
        for (int r = 0; r < 16; r++) acc[i][j][r] = sigmoidf_(acc[i][j][r]);
    f32x16 ac2[2][2]; ZERO_ACC(ac2)
    { LoadF32 la{pp + (size_t)m0 * 256, 256}; LoadBf16 lb{We + (size_t)n0 * 256, 256}; gemm_core(la, lb, 4, smem, ac2, true); }
#pragma unroll
    for (int j = 0; j < 2; j++) {
      const int tl = wn * 64 + j * 32 + l32; const size_t tg = (size_t)m0 + tl;
      float sq = 0.f;
#pragma unroll
      for (int i = 0; i < 2; i++)
#pragma unroll
        for (int rq = 0; rq < 4; rq++) {
          const int c = n0 + wm * 64 + i * 32 + 8 * rq + 4 * h;
          float4 xv = *(const float4*)(y + tg * 1024 + c);
          xv.x += acc[i][j][4 * rq] * ac2[i][j][4 * rq]; xv.y += acc[i][j][4 * rq + 1] * ac2[i][j][4 * rq + 1];
          xv.z += acc[i][j][4 * rq + 2] * ac2[i][j][4 * rq + 2]; xv.w += acc[i][j][4 * rq + 3] * ac2[i][j][4 * rq + 3];
          *(float4*)(y + tg * 1024 + c) = xv;
          if (layer == 0) {
            sq += xv.x * xv.x + xv.y * xv.y + xv.z * xv.z + xv.w * xv.w;
            store4(x2b + tg * 1024 + c, xv.x, xv.y, xv.z, xv.w);
          }
        }
      if (layer == 0) {
        sq += __shfl_xor(sq, 32);
        if (h == 0) ssx[tg * 16 + nt * 2 + wm] = sq;
      }
    }
  }
}

DI void ph_in_o(const Params& P, int g, bf16_t* smem, float* s_rs) {
  WAVE_IDS
  const int S = g ? 4096 : 8192;
  const bf16_t* x2b = (const bf16_t*)(P.ws + OFF_X2B);
  const float* ssx = (const float*)(P.ws + OFF_SSX);
  const bf16_t* W = (const bf16_t*)(P.ws + OFF_WINO);
  bf16_t* L = (bf16_t*)(P.ws + OFF_L);
  float* ssq = (float*)(P.ws + OFF_SSQ); float* sskv = (float*)(P.ws + OFF_SSKV);
  const float* ropec = (const float*)(P.ws + OFF_ROPEC); const float* ropes = (const float*)(P.ws + OFF_ROPES);
  for (int t = bid; t < 512 * 20; t += gridDim.x) {
    const int mt = t / 20, nt = t % 20; const int m0 = mt * 128, n0 = nt * 128;
    __syncthreads();
    if (tid < 128) {
      const float4* pp = (const float4*)(ssx + (size_t)(m0 + tid) * 16);
      float4 a = pp[0], b = pp[1], c = pp[2], d = pp[3];
      float s = a.x + a.y + a.z + a.w + b.x + b.y + b.z + b.w + c.x + c.y + c.z + c.w + d.x + d.y + d.z + d.w;
      s_rs[tid] = rsqrtf(s * (1.f / 1024.f) + EPS);
    }
    f32x16 acc[2][2]; ZERO_ACC(acc)
    LoadBf16 la{x2b + (size_t)m0 * 1024, 1024}; LoadBf16 lb{W + (size_t)n0 * 1024, 1024};
    const bool isY = (nt >= 8 && nt < 16);
    gemm_core(la, lb, 16, smem, acc, !isY);
    if (isY) {
      bf16_t* Yt = L + L1_YT;
#pragma unroll
      for (int j = 0; j < 2; j++) {
        const int f = (nt - 8) * 128 + wn * 64 + j * 32 + l32;
#pragma unroll
        for (int i = 0; i < 2; i++)
#pragma unroll
          for (int rq = 0; rq < 4; rq++) {
            const int tl = wm * 64 + i * 32 + 8 * rq + 4 * h; const int tg = m0 + tl; const int b = tg / S, s = tg % S;
            store4(Yt + ((size_t)b * 1024 + f) * S + s, acc[i][j][4 * rq] * s_rs[tl], acc[i][j][4 * rq + 1] * s_rs[tl + 1],
                   acc[i][j][4 * rq + 2] * s_rs[tl + 2], acc[i][j][4 * rq + 3] * s_rs[tl + 3]);
          }
      }
    } else if (nt == 3) {
      bf16_t* kr = L + L1_KR;
      if (wm == 0) {
#pragma unroll
        for (int j = 0; j < 2; j++) {
          const int tl = wn * 64 + j * 32 + l32; const size_t tg = (size_t)m0 + tl; const float rs = s_rs[tl];
          const int pos = (int)(tg % S);
#pragma unroll
          for (int rq = 0; rq < 2; rq++) {
            const int fi = 8 * rq + 4 * h;
            const float4 cv = *(const float4*)(ropec + pos * 16 + fi), sv = *(const float4*)(ropes + pos * 16 + fi);
            const float a0 = acc[0][j][4 * rq] * rs, a1 = acc[0][j][4 * rq + 1] * rs, a2 = acc[0][j][4 * rq + 2] * rs, a3 = acc[0][j][4 * rq + 3] * rs;
            const float b0 = acc[0][j][4 * rq + 8] * rs, b1 = acc[0][j][4 * rq + 9] * rs, b2 = acc[0][j][4 * rq + 10] * rs, b3 = acc[0][j][4 * rq + 11] * rs;
            store4(kr + tg * 32 + fi, a0 * cv.x - b0 * sv.x, a1 * cv.y - b1 * sv.y, a2 * cv.z - b2 * sv.z, a3 * cv.w - b3 * sv.w);
            store4(kr + tg * 32 + 16 + fi, b0 * cv.x + a0 * sv.x, b1 * cv.y + a1 * sv.y, b2 * cv.z + a2 * sv.z, b3 * cv.w + a3 * sv.w);
          }
        }
      }
    } else {
      bf16_t* dst; int ldd, cin;
      if (nt < 2) { dst = L + L1_CQ; ldd = 256; cin = nt * 128; }
      else if (nt == 2) { dst = L + L1_CKV; ldd = 128; cin = 0; }
      else if (nt < 8) { dst = L + L1_GC; ldd = 512; cin = (nt - 4) * 128; }
      else { dst = L + L1_GD; ldd = 512; cin = (nt - 16) * 128; }
#pragma unroll
      for (int j = 0; j < 2; j++) {
        const int tl = wn * 64 + j * 32 + l32; const size_t tg = (size_t)m0 + tl; const float rs = s_rs[tl];
        float sq = 0.f;
#pragma unroll
        for (int i = 0; i < 2; i++)
#pragma unroll
          for (int rq = 0; rq < 4; rq++) {
            const int c = cin + wm * 64 + i * 32 + 8 * rq + 4 * h;
            const float a0 = acc[i][j][4 * rq] * rs, a1 = acc[i][j][4 * rq + 1] * rs, a2 = acc[i][j][4 * rq + 2] * rs, a3 = acc[i][j][4 * rq + 3] * rs;
            sq += a0 * a0 + a1 * a1 + a2 * a2 + a3 * a3;
            store4(dst + tg * ldd + c, a0, a1, a2, a3);
          }
        if (nt < 3) {
          sq += __shfl_xor(sq, 32);
          if (h == 0) { if (nt < 2) ssq[tg * 4 + nt * 2 + wm] = sq; else sskv[tg * 2 + wm] = sq; }
        }
      }
    }
  }
}

DI void ph_up(const Params& P, int g, bf16_t* smem, float* s_rs) {
  WAVE_IDS
  const int S = g ? 4096 : 8192;
  bf16_t* L = (bf16_t*)(P.ws + OFF_L);
  const bf16_t* cq = L + L1_CQ; const bf16_t* ckv = L + L1_CKV;
  const float* ssq = (const float*)(P.ws + OFF_SSQ); const float* sskv = (const float*)(P.ws + OFF_SSKV);
  const bf16_t* Wuq = (const bf16_t*)(P.ws + OFF_WUQ); const bf16_t* Wukv = (const bf16_t*)(P.ws + OFF_WUKV);
  const float* ropec = (const float*)(P.ws + OFF_ROPEC); const float* ropes = (const float*)(P.ws + OFF_ROPES);
  for (int t = bid; t < 512 * 14; t += gridDim.x) {
    const int mt = t / 14, nt14 = t % 14; const int m0 = mt * 128;
    __syncthreads();
    f32x16 acc[2][2]; ZERO_ACC(acc)
    if (nt14 < 6) {
      const int nt = nt14, n0 = nt * 128;
      if (tid < 128) { const float4 a = *(const float4*)(ssq + (size_t)(m0 + tid) * 4); s_rs[tid] = rsqrtf((a.x + a.y + a.z + a.w) * (1.f / 256.f) + EPS); }
      LoadBf16 la{cq + (size_t)m0 * 256, 256}; LoadBf16 lb{Wuq + (size_t)n0 * 256, 256};
      gemm_core(la, lb, 4, smem, acc, true);
      bf16_t* Qm = L + L1_QM;
#pragma unroll
      for (int j = 0; j < 2; j++) {
        const int tl = wn * 64 + j * 32 + l32; const size_t tg = (size_t)m0 + tl; const float rs = s_rs[tl];
        const int pos = (int)(tg % S);
#pragma unroll
        for (int i = 0; i < 2; i++) {
          const int f0 = n0 + wm * 64 + i * 32;
          if ((f0 % 96) == 64) {
#pragma unroll
            for (int rq = 0; rq < 2; rq++) {
              const int fi = 8 * rq + 4 * h;
              const float4 cv = *(const float4*)(ropec + pos * 16 + fi), sv = *(const float4*)(ropes + pos * 16 + fi);
              const float a0 = acc[i][j][4 * rq] * rs, a1 = acc[i][j][4 * rq + 1] * rs, a2 = acc[i][j][4 * rq + 2] * rs, a3 = acc[i][j][4 * rq + 3] * rs;
              const float b0 = acc[i][j][4 * rq + 8] * rs, b1 = acc[i][j][4 * rq + 9] * rs, b2 = acc[i][j][4 * rq + 10] * rs, b3 = acc[i][j][4 * rq + 11] * rs;
              store4(Qm + tg * 768 + f0 + fi, a0 * cv.x - b0 * sv.x, a1 * cv.y - b1 * sv.y, a2 * cv.z - b2 * sv.z, a3 * cv.w - b3 * sv.w);
              store4(Qm + tg * 768 + f0 + 16 + fi, b0 * cv.x + a0 * sv.x, b1 * cv.y + a1 * sv.y, b2 * cv.z + a2 * sv.z, b3 * cv.w + a3 * sv.w);
            }
          } else {
#pragma unroll
            for (int rq = 0; rq < 4; rq++)
              store4(Qm + tg * 768 + f0 + 8 * rq + 4 * h, acc[i][j][4 * rq] * rs, acc[i][j][4 * rq + 1] * rs, acc[i][j][4 * rq + 2] * rs, acc[i][j][4 * rq + 3] * rs);
          }
        }
      }
    } else {
      const int nt = nt14 - 6, n0 = nt * 128;
      if (tid < 128) { const float2 a = *(const float2*)(sskv + (size_t)(m0 + tid) * 2); s_rs[tid] = rsqrtf((a.x + a.y) * (1.f / 128.f) + EPS); }
      LoadBf16 la{ckv + (size_t)m0 * 128, 128}; LoadBf16 lb{Wukv + (size_t)n0 * 128, 128};
      const bool swap = nt < 4;
      gemm_core(la, lb, 2, smem, acc, swap);
      if (swap) {
        bf16_t* Kn = L + L1_KN;
#pragma unroll
        for (int j = 0; j < 2; j++) {
          const int tl = wn * 64 + j * 32 + l32; const size_t tg = (size_t)m0 + tl; const float rs = s_rs[tl];
#pragma unroll
          for (int i = 0; i < 2; i++)
#pragma unroll
            for (int rq = 0; rq < 4; rq++)
              store4(Kn + tg * 512 + n0 + wm * 64 + i * 32 + 8 * rq + 4 * h, acc[i][j][4 * rq] * rs, acc[i][j][4 * rq + 1] * rs, acc[i][j][4 * rq + 2] * rs, acc[i][j][4 * rq + 3] * rs);
        }
      } else {
        bf16_t* Vt = L + L1_VT;
#pragma unroll
        for (int j = 0; j < 2; j++) {
          const int c = (nt - 4) * 128 + wn * 64 + j * 32 + l32; const int hh = c >> 6, d = c & 63;
#pragma unroll
          for (int i = 0; i < 2; i++)
#pragma unroll
            for (int rq = 0; rq < 4; rq++) {
              const int tl = wm * 64 + i * 32 + 8 * rq + 4 * h; const int tg = m0 + tl; const int b = tg / S, s = tg % S;
              store4(Vt + ((size_t)(b * 8 + hh) * 64 + d) * S + s, acc[i][j][4 * rq] * s_rs[tl], acc[i][j][4 * rq + 1] * s_rs[tl + 1],
                     acc[i][j][4 * rq + 2] * s_rs[tl + 2], acc[i][j][4 * rq + 3] * s_rs[tl + 3]);
            }
        }
      }
    }
  }
}

constexpr int KLD = 104, VLD = 72;
constexpr int ATT_STAGE_E = 64 * KLD + 64 * VLD;
DI void mla_item(const Params& P, int g, int item, bf16_t* smem) {
  WAVE_IDS
  const int S = g ? 4096 : 8192;
  const int nqt = S >> 7;
  const int qt = item % nqt; const int bh = item / nqt; const int hh = bh & 7, b = bh >> 3;
  const bf16_t* L = (const bf16_t*)(P.ws + OFF_L);
  const bf16_t* Qm = L + L1_QM; const bf16_t* Kn = L + L1_KN; const bf16_t* Vt = L + L1_VT; const bf16_t* Kr = L + L1_KR; const bf16_t* Gc = L + L1_GC;
  bf16_t* cat = (bf16_t*)(P.ws + OFF_CAT);
  const size_t tb = (size_t)b * S;
  const size_t tq = tb + qt * 128 + w * 32 + l32;
  bf16x8 qf[6];
#pragma unroll
  for (int kk = 0; kk < 6; kk++) qf[kk] = *(const bf16x8*)(Qm + tq * 768 + hh * 96 + kk * 16 + h * 8);
  f32x16 o[2];
#pragma unroll
  for (int i = 0; i < 2; i++)
#pragma unroll
    for (int r = 0; r < 16; r++) o[i][r] = 0.f;
  float m = -1e30f, lsum = 0.f;
  uint4 rk0, rk1, rk2, rv0, rv1;
  const bf16_t* vbase = Vt + (size_t)(b * 8 + hh) * 64 * S;
  const int kc0 = tid, kc1 = tid + 256, kc2 = tid + 512;
  const int kr0 = kc0 / 12, kq0 = kc0 % 12, kr1 = kc1 / 12, kq1 = kc1 % 12, kr2 = kc2 / 12, kq2 = kc2 % 12;
  const int vr0 = tid >> 3, vq0 = tid & 7, vr1 = (tid + 256) >> 3;
#define MLA_KSRC(row, q, k0) ((q) < 8 ? (Kn + (tb + (k0) + (row)) * 512 + hh * 64 + (q) * 8) : (Kr + (tb + (k0) + (row)) * 32 + ((q) - 8) * 8))
#define MLA_GLOAD(kt_) { const int k0_ = (kt_) * 64; \
    rk0 = *(const uint4*)MLA_KSRC(kr0, kq0, k0_); rk1 = *(const uint4*)MLA_KSRC(kr1, kq1, k0_); rk2 = *(const uint4*)MLA_KSRC(kr2, kq2, k0_); \
    rv0 = *(const uint4*)(vbase + (size_t)vr0 * S + k0_ + vq0 * 8); rv1 = *(const uint4*)(vbase + (size_t)vr1 * S + k0_ + vq0 * 8); }
#define MLA_LSTORE(buf_) { bf16_t* sK_ = smem + (buf_) * ATT_STAGE_E; bf16_t* sV_ = sK_ + 64 * KLD; \
    *(uint4*)(sK_ + kr0 * KLD + kq0 * 8) = rk0; *(uint4*)(sK_ + kr1 * KLD + kq1 * 8) = rk1; *(uint4*)(sK_ + kr2 * KLD + kq2 * 8) = rk2; \
    *(uint4*)(sV_ + vr0 * VLD + vq0 * 8) = rv0; *(uint4*)(sV_ + vr1 * VLD + vq0 * 8) = rv1; }
  const int nkt = S >> 6;
  __syncthreads();
  MLA_GLOAD(0) MLA_LSTORE(0)
  __syncthreads();
  for (int kt = 0; kt < nkt; kt++) {
    const int cur = kt & 1;
    if (kt + 1 < nkt) MLA_GLOAD(kt + 1)
    const bf16_t* sK = smem + cur * ATT_STAGE_E; const bf16_t* sV = sK + 64 * KLD;
    f32x16 s[2];
#pragma unroll
    for (int i = 0; i < 2; i++)
#pragma unroll
      for (int r = 0; r < 16; r++) s[i][r] = 0.f;
#pragma unroll
    for (int kk = 0; kk < 6; kk++) {
      bf16x8 a0 = *(const bf16x8*)(sK + l32 * KLD + kk * 16 + h * 8);
      bf16x8 a1 = *(const bf16x8*)(sK + (32 + l32) * KLD + kk * 16 + h * 8);
      s[0] = MFMA32(a0, qf[kk], s[0]); s[1] = MFMA32(a1, qf[kk], s[1]);
    }
    float mx = -1e30f;
#pragma unroll
    for (int i = 0; i < 2; i++)
#pragma unroll
      for (int r = 0; r < 16; r++) mx = fmaxf(mx, s[i][r]);
    mx = fmaxf(mx, __shfl_xor(mx, 32));
    const float mn = fmaxf(m, mx);
    const float alpha = exp2f(m - mn);
    m = mn;
    float ps = 0.f;
#pragma unroll
    for (int i = 0; i < 2; i++)
#pragma unroll
      for (int r = 0; r < 16; r++) { float p = exp2f(s[i][r] - mn); s[i][r] = p; ps += p; }
    lsum = lsum * alpha + ps;
#pragma unroll
    for (int i = 0; i < 2; i++)
#pragma unroll
      for (int r = 0; r < 16; r++) o[i][r] *= alpha;
#pragma unroll
    for (int mt2 = 0; mt2 < 2; mt2++)
#pragma unroll
      for (int st = 0; st < 2; st++) {
        const uint4 pu = make_uint4(pk2(s[mt2][8 * st], s[mt2][8 * st + 1]), pk2(s[mt2][8 * st + 2], s[mt2][8 * st + 3]),
                                    pk2(s[mt2][8 * st + 4], s[mt2][8 * st + 5]), pk2(s[mt2][8 * st + 6], s[mt2][8 * st + 7]));
        const bf16x8 pf = __builtin_bit_cast(bf16x8, pu);
        const int kb = mt2 * 32 + 16 * st + 4 * h;
#pragma unroll
        for (int dt = 0; dt < 2; dt++) {
          const bf16_t* vp = sV + (dt * 32 + l32) * VLD + kb;
          const uint2 lo = *(const uint2*)vp, hi = *(const uint2*)(vp + 8);
          const bf16x8 av = __builtin_bit_cast(bf16x8, make_uint4(lo.x, lo.y, hi.x, hi.y));
          o[dt] = MFMA32(av, pf, o[dt]);
        }
      }
    if (kt + 1 < nkt) MLA_LSTORE(cur ^ 1)
    __syncthreads();
  }
  lsum += __shfl_xor(lsum, 32);
  const float inv = 1.f / lsum;
#pragma unroll
  for (int dt = 0; dt < 2; dt++)
#pragma unroll
    for (int rq = 0; rq < 4; rq++) {
      const int dv = hh * 64 + dt * 32 + 8 * rq + 4 * h;
      const uint2 gu = *(const uint2*)(Gc + tq * 512 + dv);
      store4(cat + tq * 1024 + dv, o[dt][4 * rq] * inv * siluf_(bflo(gu.x)), o[dt][4 * rq + 1] * inv * siluf_(bfhi(gu.x)),
             o[dt][4 * rq + 2] * inv * siluf_(bflo(gu.y)), o[dt][4 * rq + 3] * inv * siluf_(bfhi(gu.y)));
    }
}

DI void dft_item(const Params& P, int g, int item, bf16_t* smem) {
  WAVE_IDS
  const int S = g ? 4096 : 8192;
  const int mt = item >> 2, ntc = item & 3; const int m0 = mt * 128, n0 = ntc * 128;
  const int b = m0 / S, ks0 = m0 % S;
  const bf16_t* L = (const bf16_t*)(P.ws + OFF_L);
  const bf16_t* Yt = L + L1_YT; const bf16_t* Gd = L + L1_GD;
  bf16_t* cat = (bf16_t*)(P.ws + OFF_CAT);
  __syncthreads();
  f32x16 acc[2][2]; ZERO_ACC(acc)
  LoadDft la; la.ks0 = ks0; la.S = S; la.invS = 1.f / (float)S; la.init(tid);
  LoadYt lb{Yt + ((size_t)b * 1024 + n0) * S, S};
  gemm_core(la, lb, S >> 5, smem, acc, true);
  const float scale = rsqrtf((float)S * 128.f);
#pragma unroll
  for (int j = 0; j < 2; j++) {
    const int tl = wn * 64 + j * 32 + l32; const size_t tg = (size_t)m0 + tl;
#pragma unroll
    for (int i = 0; i < 2; i++)
#pragma unroll
      for (int rq = 0; rq < 4; rq++) {
        const int ch = n0 + wm * 64 + i * 32 + 8 * rq + 4 * h;
        const uint2 gu = *(const uint2*)(Gd + tg * 512 + ch);
        store4(cat + tg * 1024 + 512 + ch, acc[i][j][4 * rq] * scale * siluf_(bflo(gu.x)), acc[i][j][4 * rq + 1] * scale * siluf_(bfhi(gu.x)),
               acc[i][j][4 * rq + 2] * scale * siluf_(bflo(gu.y)), acc[i][j][4 * rq + 3] * scale * siluf_(bfhi(gu.y)));
      }
  }
}

DI void ph_mix_o(const Params& P, int g, bf16_t* smem) {
  const int S = g ? 4096 : 8192; const int B = g ? 16 : 8;
  const int nmla = B * 8 * (S >> 7), ndft = 512 * 4;
  for (int it = obid(); it < nmla + ndft; it += gridDim.x) {
    if (it < nmla) mla_item(P, g, it, smem); else dft_item(P, g, it - nmla, smem);
  }
}

constexpr int NPH = 23;
#ifndef ONLY_SUB
#define ONLY_SUB -1
#endif
DI void run_phase(const Params& P, int ph, bf16_t* smem, float* s_rs) {
  if (ph == 0) { if (ONLY_SUB < 0 || ONLY_SUB == 99) ph_prelude(P); return; }
  const int g = (ph - 1) / 11; int sub = (ph - 1) % 11;
  if (ONLY_SUB >= 0) { if (sub != ONLY_SUB) return; sub = ONLY_SUB; }
  switch (sub) {
    case 0: ph_in_e(P, g, smem, s_rs); break;
    case 1: ph_mix_e(P, g, smem); break;
    case 2: ph_out(P, 0, smem); break;
    case 3: ph_resid(P, g, 0); break;
    case 4: ph_ple(P, g, 0, smem); break;
    case 5: ph_in_o(P, g, smem, s_rs); break;
    case 6: ph_up(P, g, smem, s_rs); break;
    case 7: ph_mix_o(P, g, smem); break;
    case 8: ph_out(P, 1, smem); break;
    case 9: ph_resid(P, g, 1); break;
    default: ph_ple(P, g, 1, smem); break;
  }
}

__global__ void __launch_bounds__(NTHR, 2) mega(Params P, int ph_lo, int ph_hi) {
  __shared__ __attribute__((aligned(16))) bf16_t smem[SMEM_E];
  __shared__ float s_rs[128];
  for (int ph = ph_lo; ph < ph_hi; ph++) {
    run_phase(P, ph, smem, s_rs);
    if (ph + 1 < ph_hi) cg::this_grid().sync();
  }
}

extern "C" void kernel_launch(void* const* d_in, const int* in_sizes, int n_in, void* d_out, int out_size, void* d_ws, size_t ws_size,
                              hipStream_t stream) {
  static int grid_blocks = 0;
  if (!grid_blocks) {
    int dev = 0, cus = 0, per_cu = 0;
    hipGetDevice(&dev);
    hipDeviceGetAttribute(&cus, hipDeviceAttributeMultiprocessorCount, dev);
    hipOccupancyMaxActiveBlocksPerMultiprocessor(&per_cu, mega, NTHR, 0);
    if (per_cu < 1) per_cu = 1;
    if (per_cu > 2) per_cu = 2;
    grid_blocks = cus * per_cu;
  }
  Params P{};
  P.x0 = (const float*)d_in[0]; P.x1 = (const float*)d_in[1]; P.p0 = (const float*)d_in[2]; P.p1 = (const float*)d_in[3];
  P.y0 = (float*)d_out; P.y1 = (float*)d_out + (size_t)TOK * 1024;
  P.g_pre = (const float*)d_in[4]; P.g_post = (const float*)d_in[5]; P.w_ple = (const float*)d_in[6]; P.w_ple_gate = (const float*)d_in[7];
  P.w_in_e = (const float*)d_in[8]; P.rpb = (const float*)d_in[9]; P.dw_w = (const float*)d_in[10]; P.dw_b = (const float*)d_in[11];
  P.cln_g = (const float*)d_in[12]; P.cln_b = (const float*)d_in[13]; P.w_out_e = (const float*)d_in[14]; P.w_in_o = (const float*)d_in[15];
  P.q_norm_g = (const float*)d_in[16]; P.kv_norm_g = (const float*)d_in[17]; P.w_uq = (const float*)d_in[18]; P.w_ukv = (const float*)d_in[19];
  P.w_out_o = (const float*)d_in[20];
  P.ws = (char*)d_ws;
  for (int i = 0; i < 16; i++) P.inv_freq[i] = powf(10000.0f, -(float)(2 * i) / 32.0f);
#if MK_COOP
  int lo = 0, hi = NPH;
  void* args[] = {&P, &lo, &hi};
  hipError_t e = hipLaunchCooperativeKernel((void*)mega, dim3(grid_blocks), dim3(NTHR), args, 0, stream);
  if (e != hipSuccess) fprintf(stderr, "cooperative launch failed: %s (grid %d)\n", hipGetErrorString(e), grid_blocks);
#else
  for (int ph = 0; ph < NPH; ph++) mega<<<dim3(grid_blocks), dim3(NTHR), 0, stream>>>(P, ph, ph + 1);
#endif
}
```

```cpp
#include <hip/hip_runtime.h>
#include <hip/hip_cooperative_groups.h>
#include <cstdio>
#include <cmath>
namespace cg = cooperative_groups;

#ifndef MK_COOP
#define MK_COOP 1
#endif

typedef unsigned short bf16_t;
typedef short bf16x8 __attribute__((ext_vector_type(8)));
typedef float f32x16 __attribute__((ext_vector_type(16)));
typedef float f32x4 __attribute__((ext_vector_type(4)));
typedef __bf16 bf16v2 __attribute__((ext_vector_type(2)));
typedef float f32v2 __attribute__((ext_vector_type(2)));
#define DI __device__ __forceinline__
#define MFMA32(a, b, c) __builtin_amdgcn_mfma_f32_32x32x16_bf16((a), (b), (c), 0, 0, 0)
#define MFMA16(a, b, c) __builtin_amdgcn_mfma_f32_16x16x32_bf16((a), (b), (c), 0, 0, 0)

constexpr int TOK = 65536;
constexpr float EPS = 1e-6f;
constexpr float LOG2E = 1.4426950408889634f;
constexpr int NTHR = 256;

constexpr size_t MBy = 1u << 20;
constexpr size_t OFF_WINE = 0;
constexpr size_t OFF_WOUTE = 7 * MBy;
constexpr size_t OFF_WOUTO = 9 * MBy;
constexpr size_t OFF_WG0 = 11 * MBy;
constexpr size_t OFF_WG1 = 13 * MBy;
constexpr size_t OFF_WE0 = 15 * MBy;
constexpr size_t OFF_WE1 = 15 * MBy + 512 * 1024;
constexpr size_t OFF_WINO = 16 * MBy;
constexpr size_t OFF_WUQ = 21 * MBy;
constexpr size_t OFF_WUKV = 21 * MBy + 512 * 1024;
constexpr size_t OFF_ROPEC = 22 * MBy;
constexpr size_t OFF_ROPES = 22 * MBy + 512 * 1024;
constexpr size_t OFF_RSIN = 23 * MBy;
constexpr size_t OFF_SS = 24 * MBy;
constexpr size_t OFF_SSX = 28 * MBy;
constexpr size_t OFF_SSQ = 32 * MBy;
constexpr size_t OFF_SSKV = 33 * MBy;
constexpr size_t OFF_CAT = 34 * MBy;
constexpr size_t OFF_X2B = 162 * MBy;
constexpr size_t OFF_L = 290 * MBy;
constexpr size_t ME = 1u << 20;
constexpr size_t L0_Q = 0, L0_K = 32 * ME, L0_VT = 64 * ME, L0_GA = 96 * ME, L0_UA = 128 * ME, L0_UB = 160 * ME, L0_GB = 192 * ME;
constexpr size_t L0_OB = 0, L0_X1B = 128 * ME;
constexpr size_t L1_YT = 0, L1_QM = 64 * ME, L1_KN = 112 * ME, L1_VT = 144 * ME, L1_GC = 176 * ME, L1_GD = 208 * ME,
                 L1_CQ = 240 * ME, L1_CKV = 256 * ME, L1_KR = 264 * ME;
constexpr size_t L1_OB = 0, L1_X1B = 64 * ME;

struct Params {
  const float* x0; const float* x1; const float* p0; const float* p1;
  float* y0; float* y1;
  const float* g_pre; const float* g_post; const float* w_ple; const float* w_ple_gate;
  const float* w_in_e; const float* rpb; const float* dw_w; const float* dw_b; const float* cln_g; const float* cln_b;
  const float* w_out_e; const float* w_in_o; const float* q_norm_g; const float* kv_norm_g;
  const float* w_uq; const float* w_ukv; const float* w_out_o;
  char* ws;
  float inv_freq[16];
};

DI unsigned pk2(float a, float b) { f32v2 v = {a, b}; return __builtin_bit_cast(unsigned, __builtin_convertvector(v, bf16v2)); }
DI float bflo(unsigned u) { return __uint_as_float(u << 16); }
DI float bfhi(unsigned u) { return __uint_as_float(u & 0xffff0000u); }
DI float sigmoidf_(float v) { return 1.f / (1.f + __expf(-v)); }
DI float siluf_(float v) { return v / (1.f + __expf(-v)); }
DI void store4(bf16_t* p, float a, float b, float c, float d) { *(uint2*)p = make_uint2(pk2(a, b), pk2(c, d)); }
DI int otid() { int t = threadIdx.x; asm volatile("" : "+v"(t)); return t; }
DI int obid() { int t = blockIdx.x; asm volatile("" : "+s"(t)); return t; }
DI float wave_sum(float s) {
#pragma unroll
  for (int o = 32; o; o >>= 1) s += __shfl_xor(s, o);
  return s;
}

constexpr int LDT = 72;
constexpr int TILE_E = 128 * LDT;
constexpr int SMEM_E = 4 * TILE_E;

struct LoadBf16 {
  static constexpr bool LATE = false;
  const bf16_t* base; int ld;
  DI void pos(int i, int tid, int& row, int& kc) const { int c = tid + 256 * i; row = c >> 3; kc = c & 7; }
  DI uint4 ld1(int kt, int i, int tid) const { int row, kc; pos(i, tid, row, kc); return *(const uint4*)(base + (size_t)row * ld + kt * 64 + kc * 8); }
  DI void load(int kt, int tid, uint4& r0, uint4& r1, uint4& r2, uint4& r3) const { r0 = ld1(kt, 0, tid); r1 = ld1(kt, 1, tid); r2 = ld1(kt, 2, tid); r3 = ld1(kt, 3, tid); }
};
struct LoadF32 {
  static constexpr bool LATE = false;
  const float* base; int ld;
  DI void pos(int i, int tid, int& row, int& kc) const { int c = tid + 256 * i; row = c >> 3; kc = c & 7; }
  DI uint4 ld1(int kt, int i, int tid) const {
    int row, kc; pos(i, tid, row, kc);
    const float* s = base + (size_t)row * ld + kt * 64 + kc * 8;
    float4 a = *(const float4*)s, b = *(const float4*)(s + 4);
    return make_uint4(pk2(a.x, a.y), pk2(a.z, a.w), pk2(b.x, b.y), pk2(b.z, b.w));
  }
  DI void load(int kt, int tid, uint4& r0, uint4& r1, uint4& r2, uint4& r3) const { r0 = ld1(kt, 0, tid); r1 = ld1(kt, 1, tid); r2 = ld1(kt, 2, tid); r3 = ld1(kt, 3, tid); }
};
struct LoadYt {
  static constexpr bool LATE = false;
  const bf16_t* base; int S;
  DI void pos(int i, int tid, int& row, int& kc) const { int c = tid + 256 * i; row = c >> 3; kc = c & 7; }
  DI uint4 ld1(int kt, int i, int tid) const { int row, kc; pos(i, tid, row, kc); return *(const uint4*)(base + (size_t)(row + (kc >> 2) * 512) * S + kt * 32 + (kc & 3) * 8); }
  DI void load(int kt, int tid, uint4& r0, uint4& r1, uint4& r2, uint4& r3) const { r0 = ld1(kt, 0, tid); r1 = ld1(kt, 1, tid); r2 = ld1(kt, 2, tid); r3 = ld1(kt, 3, tid); }
};
struct LoadDft {
  static constexpr bool LATE = true;
  int ks0, S; float invS; float cd0, sd0, cd1, sd1;
  DI void init(int tid) {
    { int row = tid >> 2; float f = (float)(ks0 + row) * invS; cd0 = __builtin_amdgcn_cosf(f); sd0 = __builtin_amdgcn_sinf(f); }
    { int row = (tid + 256) >> 2; float f = (float)(ks0 + row) * invS; cd1 = __builtin_amdgcn_cosf(f); sd1 = __builtin_amdgcn_sinf(f); }
  }
  DI void pos(int i, int tid, int& row, int& kc) const { int q = tid + 256 * (i >> 1); row = q >> 2; kc = (q & 3) + 4 * (i & 1); }
  DI void gen(int kt, int q, float cd, float sd, uint4& rc, uint4& rs) const {
    const int row = q >> 2, seg = q & 3;
    const int ks = ks0 + row; const int sst = kt * 32 + seg * 8;
    const int idx = (ks * sst) & (S - 1);
    const float f = (float)idx * invS;
    const float c0 = __builtin_amdgcn_cosf(f), s0 = __builtin_amdgcn_sinf(f);
    const float c1 = c0 * cd - s0 * sd, s1 = s0 * cd + c0 * sd;
    const float c2 = c1 * cd - s1 * sd, s2 = s1 * cd + c1 * sd;
    const float c3 = c2 * cd - s2 * sd, s3 = s2 * cd + c2 * sd;
    const float c4 = c3 * cd - s3 * sd, s4 = s3 * cd + c3 * sd;
    const float c5 = c4 * cd - s4 * sd, s5 = s4 * cd + c4 * sd;
    const float c6 = c5 * cd - s5 * sd, s6 = s5 * cd + c5 * sd;
    const float c7 = c6 * cd - s6 * sd, s7 = s6 * cd + c6 * sd;
    rc = make_uint4(pk2(c0, c1), pk2(c2, c3), pk2(c4, c5), pk2(c6, c7));
    rs = make_uint4(pk2(-s0, -s1), pk2(-s2, -s3), pk2(-s4, -s5), pk2(-s6, -s7));
  }
  DI void load(int kt, int tid, uint4& r0, uint4& r1, uint4& r2, uint4& r3) const { gen(kt, tid, cd0, sd0, r0, r1); gen(kt, tid + 256, cd1, sd1, r2, r3); }
};

#define GEMM_ST1(sA_, i_, va_, vb_) { int row, kc; la.pos(i_, tid, row, kc); *(uint4*)((sA_) + row * LDT + kc * 8) = va_; \
    lb.pos(i_, tid, row, kc); *(uint4*)((sA_) + TILE_E + row * LDT + kc * 8) = vb_; }
DI void gemm_mma(const bf16_t* sA, f32x16 (&acc)[2][2], const bool swap, int moff, int noff) {
  const bf16_t* sB = sA + TILE_E;
  const bf16_t* sM = swap ? sB : sA; const bf16_t* sN = swap ? sA : sB;
#pragma unroll
  for (int kk = 0; kk < 4; kk++) {
    bf16x8 fm0 = *(const bf16x8*)(sM + moff + kk * 16);
    bf16x8 fm1 = *(const bf16x8*)(sM + moff + 32 * LDT + kk * 16);
    bf16x8 fn0 = *(const bf16x8*)(sN + noff + kk * 16);
    bf16x8 fn1 = *(const bf16x8*)(sN + noff + 32 * LDT + kk * 16);
    acc[0][0] = MFMA32(fm0, fn0, acc[0][0]); acc[0][1] = MFMA32(fm0, fn1, acc[0][1]);
    acc[1][0] = MFMA32(fm1, fn0, acc[1][0]); acc[1][1] = MFMA32(fm1, fn1, acc[1][1]);
  }
}
template <class LA, class LB>
DI void gemm_core(const LA& la, const LB& lb, const int nk, bf16_t* smem, f32x16 (&acc)[2][2], const bool swap) {
  const int tid = otid();
  const int lane = tid & 63, w = tid >> 6, wm = w >> 1, wn = w & 1, l32 = lane & 31, h = lane >> 5;
  uint4 a00, a01, a02, a03, b00, b01, b02, b03, a10, a11, a12, a13, b10, b11, b12, b13;
  const int last = nk - 1;
  la.load(0, tid, a00, a01, a02, a03); lb.load(0, tid, b00, b01, b02, b03);
  { const int k1 = last < 1 ? last : 1; if (!LA::LATE) la.load(k1, tid, a10, a11, a12, a13); lb.load(k1, tid, b10, b11, b12, b13); }
  bf16_t* buf0 = smem; bf16_t* buf1 = smem + 2 * TILE_E;
  GEMM_ST1(buf0, 0, a00, b00) GEMM_ST1(buf0, 1, a01, b01) GEMM_ST1(buf0, 2, a02, b02) GEMM_ST1(buf0, 3, a03, b03)
  __syncthreads();
  const int moff = (wm * 64 + l32) * LDT + h * 8;
  const int noff = (wn * 64 + l32) * LDT + h * 8;
  for (int kt = 0; kt < nk; kt += 2) {
    { const int k2 = (kt + 2 < nk) ? kt + 2 : last; if (!LA::LATE) la.load(k2, tid, a00, a01, a02, a03); lb.load(k2, tid, b00, b01, b02, b03); }
    gemm_mma(buf0, acc, swap, moff, noff);
    if (LA::LATE) la.load(kt + 1, tid, a10, a11, a12, a13);
    GEMM_ST1(buf1, 0, a10, b10) GEMM_ST1(buf1, 1, a11, b11) GEMM_ST1(buf1, 2, a12, b12) GEMM_ST1(buf1, 3, a13, b13)
    __syncthreads();
    { const int k3 = (kt + 3 < nk) ? kt + 3 : last; if (!LA::LATE) la.load(k3, tid, a10, a11, a12, a13); lb.load(k3, tid, b10, b11, b12, b13); }
    gemm_mma(buf1, acc, swap, moff, noff);
    if (LA::LATE) { const int k2 = (kt + 2 < nk) ? kt + 2 : last; la.load(k2, tid, a00, a01, a02, a03); }
    GEMM_ST1(buf0, 0, a00, b00) GEMM_ST1(buf0, 1, a01, b01) GEMM_ST1(buf0, 2, a02, b02) GEMM_ST1(buf0, 3, a03, b03)
    __syncthreads();
  }
}

DI bool tile_sched(int bid, int it, int NT, int PW, int& mt, int& nt) {
  const int x = bid & 7, slot = bid >> 3, nslot = gridDim.x >> 3;
  const int j = slot + it * nslot;
  if (j >= 64 * NT) return false;
  const int ppan = 64 * PW; const int panel = j / ppan, rem = j - panel * ppan;
  const int ml = rem / PW; nt = panel * PW + (rem - ml * PW); mt = x * 64 + ml;
  return true;
}

#define ZERO_ACC(a) { _Pragma("unroll") for (int i_ = 0; i_ < 2; i_++) _Pragma("unroll") for (int j_ = 0; j_ < 2; j_++) _Pragma("unroll") for (int r_ = 0; r_ < 16; r_++) a[i_][j_][r_] = 0.f; }
#define WAVE_IDS const int tid = otid(); const int bid = obid(); (void)bid; const int lane = tid & 63, w = tid >> 6, wm = w >> 1, wn = w & 1, l32 = lane & 31, h = lane >> 5; (void)lane; (void)wm; (void)wn; (void)l32; (void)h;

template <class F>
DI void cvt_task(bf16_t* dst, int N, int K, F f, int gt, int gs) {
  const int nu = N * (K >> 3);
  for (int u = gt; u < nu; u += gs) {
    int n = u % N, kc = u / N; float v[8];
#pragma unroll
    for (int j = 0; j < 8; j++) v[j] = f(kc * 8 + j, n);
    *(uint4*)(dst + (size_t)n * K + kc * 8) = make_uint4(pk2(v[0], v[1]), pk2(v[2], v[3]), pk2(v[4], v[5]), pk2(v[6], v[7]));
  }
}

DI void ph_prelude(const Params& P) {
  const int tid0 = otid();
  const int gt = obid() * NTHR + tid0, gs = gridDim.x * NTHR;
  char* ws = P.ws;
  { const float* w = P.w_in_e; const float* gp = P.g_pre;
    cvt_task((bf16_t*)(ws + OFF_WINE), 3584, 1024, [=](int k, int n) { return w[(size_t)k * 3584 + n] * gp[k] * (n < 512 ? 0.125f * LOG2E : 1.f); }, gt, gs); }
  { const float* w = P.w_out_e; cvt_task((bf16_t*)(ws + OFF_WOUTE), 1024, 1024, [=](int k, int n) { return w[(size_t)k * 1024 + n]; }, gt, gs); }
  { const float* w = P.w_out_o; cvt_task((bf16_t*)(ws + OFF_WOUTO), 1024, 1024, [=](int k, int n) { return w[(size_t)k * 1024 + n]; }, gt, gs); }
  { const float* w = P.w_ple_gate; cvt_task((bf16_t*)(ws + OFF_WG0), 1024, 1024, [=](int k, int n) { return w[(size_t)k * 1024 + n]; }, gt, gs); }
  { const float* w = P.w_ple_gate + 1024 * 1024; cvt_task((bf16_t*)(ws + OFF_WG1), 1024, 1024, [=](int k, int n) { return w[(size_t)k * 1024 + n]; }, gt, gs); }
  { const float* w = P.w_ple; cvt_task((bf16_t*)(ws + OFF_WE0), 1024, 256, [=](int k, int n) { return w[(size_t)k * 1024 + n]; }, gt, gs); }
  { const float* w = P.w_ple + 256 * 1024; cvt_task((bf16_t*)(ws + OFF_WE1), 1024, 256, [=](int k, int n) { return w[(size_t)k * 1024 + n]; }, gt, gs); }
  {
    const float* w = P.w_in_o; const float* gp = P.g_pre + 1024;
    cvt_task((bf16_t*)(ws + OFF_WINO), 1024, 1024, [=](int k, int n) {
      int col; if (n < 384) col = n; else if (n < 512) { col = (n < 416) ? n : -1; } else col = 416 + (n - 512);
      return col < 0 ? 0.f : w[(size_t)k * 1952 + col] * gp[k]; }, gt, gs);
    cvt_task((bf16_t*)(ws + OFF_WINO) + (size_t)2048 * 1024, 512, 1024, [=](int k, int n) { return w[(size_t)k * 1952 + 1440 + n] * gp[k]; }, gt, gs);
    bf16_t* dst = (bf16_t*)(ws + OFF_WINO) + (size_t)1024 * 1024;
    for (int u = gt; u < 1024 * 128; u += gs) {
      int nn = u & 1023, kcb = u >> 10; int part = nn >> 9, ch = nn & 511, gi = ch >> 7, kc_ = ch & 127;
      float a[8];
#pragma unroll
      for (int j = 0; j < 8; j++) a[j] = 0.f;
      const float* wp = w + 928 + gi * 128 + (size_t)(kcb * 8) * 1952;
      for (int c = 0; c < 128; c++) {
        float f = (float)((kc_ * c) & 127) * (1.f / 128.f);
        float tr = part ? __builtin_amdgcn_sinf(f) : __builtin_amdgcn_cosf(f);
#pragma unroll
        for (int j = 0; j < 8; j++) a[j] += wp[(size_t)j * 1952 + c] * tr;
      }
#pragma unroll
      for (int j = 0; j < 8; j++) a[j] *= gp[kcb * 8 + j];
      *(uint4*)(dst + (size_t)nn * 1024 + kcb * 8) = make_uint4(pk2(a[0], a[1]), pk2(a[2], a[3]), pk2(a[4], a[5]), pk2(a[6], a[7]));
    }
  }
  { const float* w = P.w_uq; const float* gq = P.q_norm_g; const float sc = 0.10206207261596577f * LOG2E;
    cvt_task((bf16_t*)(ws + OFF_WUQ), 768, 256, [=](int k, int n) { return w[(size_t)k * 768 + n] * gq[k] * sc; }, gt, gs); }
  { const float* w = P.w_ukv; const float* gk = P.kv_norm_g;
    cvt_task((bf16_t*)(ws + OFF_WUKV), 1024, 128, [=](int k, int n) {
      int col = (n < 512) ? ((n >> 6) * 128 + (n & 63)) : (((n - 512) >> 6) * 128 + 64 + (n & 63));
      return w[(size_t)k * 1024 + col] * gk[k]; }, gt, gs); }
  { float* rc = (float*)(ws + OFF_ROPEC); float* rsn = (float*)(ws + OFF_ROPES);
    for (int u = gt; u < 8192 * 16; u += gs) {
      int pos = u >> 4, i = u & 15;
      float fr = P.inv_freq[0];
#pragma unroll
      for (int k = 1; k < 16; k++) fr = (i == k) ? P.inv_freq[k] : fr;
      float ang = (float)pos * fr;
      double t = (double)ang * 0.15915494309189535; t -= floor(t);
      float f = (float)t;
      rc[u] = __builtin_amdgcn_cosf(f); rsn[u] = __builtin_amdgcn_sinf(f);
    } }
}

DI void ph_xprep(const Params& P, int g) {
  const int tid0 = otid(); const int lane = tid0 & 63;
  const int wid = (obid() * NTHR + tid0) >> 6, nw = (gridDim.x * NTHR) >> 6;
  const float* x = g ? P.x1 : P.x0;
  float* rs = (float*)(P.ws + OFF_RSIN) + g * TOK;
  bf16_t* xb = (bf16_t*)(P.ws + OFF_X2B);
  for (int t = wid; t < TOK; t += nw) {
    const float* xr = x + (size_t)t * 1024;
    float s = 0.f;
#pragma unroll
    for (int k = 0; k < 4; k++) {
      const int f = (k * 64 + lane) * 4;
      float4 v = *(const float4*)(xr + f); s += v.x * v.x + v.y * v.y + v.z * v.z + v.w * v.w;
      store4(xb + (size_t)t * 1024 + f, v.x, v.y, v.z, v.w);
    }
    s = wave_sum(s);
    if (lane == 0) rs[t] = rsqrtf(s * (1.f / 1024.f) + EPS);
  }
}

DI void ph_in_e(const Params& P, int g, bf16_t* smem, float* s_rs) {
  WAVE_IDS
  const int S = g ? 4096 : 8192;
  const bf16_t* xb = (const bf16_t*)(P.ws + OFF_X2B);
  const float* rs_in = (const float*)(P.ws + OFF_RSIN) + g * TOK;
  const bf16_t* W = (const bf16_t*)(P.ws + OFF_WINE);
  bf16_t* L = (bf16_t*)(P.ws + OFF_L);
  for (int it = 0;; it++) {
    int mt, nt; if (!tile_sched(bid, it, 28, 7, mt, nt)) break;
    const int m0 = mt * 128, n0 = nt * 128; const int split = nt >> 2, cin = (nt & 3) * 128;
    __syncthreads();
    if (tid < 128) s_rs[tid] = rs_in[m0 + tid];
    f32x16 acc[2][2]; ZERO_ACC(acc)
    LoadBf16 la{xb + (size_t)m0 * 1024, 1024}; LoadBf16 lb{W + (size_t)n0 * 1024, 1024};
    const bool swap = (split != 2);
    gemm_core(la, lb, 16, smem, acc, swap);
    if (swap) {
      bf16_t* dst = L + (size_t)split * 32 * ME;
#pragma unroll
      for (int j = 0; j < 2; j++) {
        const int tl = wn * 64 + j * 32 + l32; const float rs = s_rs[tl];
        bf16_t* drow = dst + (size_t)(m0 + tl) * 512 + cin;
#pragma unroll
        for (int i = 0; i < 2; i++)
#pragma unroll
          for (int rq = 0; rq < 4; rq++) {
            const int c = wm * 64 + i * 32 + 8 * rq + 4 * h;
            store4(drow + c, acc[i][j][4 * rq] * rs, acc[i][j][4 * rq + 1] * rs, acc[i][j][4 * rq + 2] * rs, acc[i][j][4 * rq + 3] * rs);
          }
      }
    } else {
      bf16_t* Vt = L + L0_VT;
#pragma unroll
      for (int j = 0; j < 2; j++) {
        const int c = cin + wn * 64 + j * 32 + l32; const int hh = c >> 6, d = c & 63;
#pragma unroll
        for (int i = 0; i < 2; i++)
#pragma unroll
          for (int rq = 0; rq < 4; rq++) {
            const int tl = wm * 64 + i * 32 + 8 * rq + 4 * h; const int tg = m0 + tl; const int b = tg / S, s = tg % S;
            store4(Vt + ((size_t)(b * 8 + hh) * 64 + d) * S + s, acc[i][j][4 * rq] * s_rs[tl], acc[i][j][4 * rq + 1] * s_rs[tl + 1],
                   acc[i][j][4 * rq + 2] * s_rs[tl + 2], acc[i][j][4 * rq + 3] * s_rs[tl + 3]);
          }
      }
    }
  }
}

DI void na_item(const Params& P, int g, int item, bf16_t* smem) {
  const int tid = otid(), lane = tid & 63, w = tid >> 6, q = lane & 15, gq = lane >> 4;
  const int S = g ? 4096 : 8192; const int rows = S >> 6;
  const int hh = item & 7; const int br = item >> 3; const int r = br % rows, b = br / rows;
  float* s_rpb = (float*)smem;
  __syncthreads();
  for (int i = tid; i < 465; i += NTHR) s_rpb[i] = P.rpb[hh * 465 + i] * LOG2E;
  __syncthreads();
  const bf16_t* L = (const bf16_t*)(P.ws + OFF_L);
  const bf16_t* Qb = L + L0_Q; const bf16_t* Kb = L + L0_K; const bf16_t* Vt = L + L0_VT; const bf16_t* Ga = L + L0_GA;
  bf16_t* cat = (bf16_t*)(P.ws + OFF_CAT);
  int rs_ = r - 4; rs_ = rs_ < 0 ? 0 : rs_; rs_ = rs_ > rows - 8 ? rows - 8 : rs_;
  const int cb = (w == 0) ? 0 : (w == 1) ? 8 : (w == 2) ? 24 : 32;
  const int c = 16 * w + q; int cs = c - 8; cs = cs < 0 ? 0 : cs; cs = cs > 48 ? 48 : cs;
  const size_t tb = (size_t)b * S;
  const bf16_t* qp = Qb + (tb + r * 64 + c) * 512 + hh * 64 + gq * 8;
  const bf16x8 qf0 = *(const bf16x8*)qp, qf1 = *(const bf16x8*)(qp + 32);
  f32x4 sc[8][2];
#pragma unroll
  for (int kr = 0; kr < 8; kr++)
#pragma unroll
    for (int T = 0; T < 2; T++) {
      const bf16_t* kp = Kb + (tb + (rs_ + kr) * 64 + cb + 16 * T + q) * 512 + hh * 64 + gq * 8;
      bf16x8 k0 = *(const bf16x8*)kp, k1 = *(const bf16x8*)(kp + 32);
      f32x4 a = {0.f, 0.f, 0.f, 0.f};
      a = MFMA16(k0, qf0, a); a = MFMA16(k1, qf1, a);
      sc[kr][T] = a;
    }
  float mx = -1e30f;
#pragma unroll
  for (int kr = 0; kr < 8; kr++)
#pragma unroll
    for (int T = 0; T < 2; T++)
#pragma unroll
      for (int i = 0; i < 4; i++) {
        const int kc = cb + 16 * T + 4 * gq + i;
        const bool valid = (kc >= cs) && (kc < cs + 16);
        const int dr = rs_ + kr - r + 7, dc = kc - c + 15;
        const float bias = s_rpb[valid ? dr * 31 + dc : 0];
        const float v = valid ? sc[kr][T][i] + bias : -1e30f;
        sc[kr][T][i] = v; mx = fmaxf(mx, v);
      }
  mx = fmaxf(mx, __shfl_xor(mx, 16)); mx = fmaxf(mx, __shfl_xor(mx, 32));
  float sum = 0.f;
#pragma unroll
  for (int kr = 0; kr < 8; kr++)
#pragma unroll
    for (int T = 0; T < 2; T++)
#pragma unroll
      for (int i = 0; i < 4; i++) { float p = __builtin_amdgcn_exp2f(sc[kr][T][i] - mx); sc[kr][T][i] = p; sum += p; }
  sum += __shfl_xor(sum, 16); sum += __shfl_xor(sum, 32);
  f32x4 o[4];
#pragma unroll
  for (int m = 0; m < 4; m++) o[m] = f32x4{0.f, 0.f, 0.f, 0.f};
#pragma unroll
  for (int kr = 0; kr < 8; kr++) {
    uint4 pu = make_uint4(pk2(sc[kr][0][0], sc[kr][0][1]), pk2(sc[kr][0][2], sc[kr][0][3]), pk2(sc[kr][1][0], sc[kr][1][1]), pk2(sc[kr][1][2], sc[kr][1][3]));
    const bf16x8 pb = __builtin_bit_cast(bf16x8, pu);
#pragma unroll
    for (int m = 0; m < 4; m++) {
      const bf16_t* vp = Vt + ((size_t)(b * 8 + hh) * 64 + m * 16 + q) * S + (rs_ + kr) * 64 + cb + 4 * gq;
      uint2 lo = *(const uint2*)vp, hi = *(const uint2*)(vp + 16);
      const bf16x8 av = __builtin_bit_cast(bf16x8, make_uint4(lo.x, lo.y, hi.x, hi.y));
      o[m] = MFMA16(av, pb, o[m]);
    }
  }
  const float inv = 1.f / sum;
  const size_t tq = tb + r * 64 + c;
#pragma unroll
  for (int m = 0; m < 4; m++) {
    const int dv = hh * 64 + m * 16 + 4 * gq;
    uint2 gu = *(const uint2*)(Ga + tq * 512 + dv);
    store4(cat + tq * 1024 + dv, o[m][0] * inv * siluf_(bflo(gu.x)), o[m][1] * inv * siluf_(bfhi(gu.x)),
           o[m][2] * inv * siluf_(bflo(gu.y)), o[m][3] * inv * siluf_(bfhi(gu.y)));
  }
}

DI void conv_item(const Params& P, int g, int item, bf16_t* smem) {
  const int tid = otid(), lane = tid & 63, w = tid >> 6;
  const int S = g ? 4096 : 8192;
  const int t0 = item * 32; const int b = t0 / S, s0 = t0 % S;
  const bf16_t* L = (const bf16_t*)(P.ws + OFF_L);
  const bf16_t* Ua = L + L0_UA; const bf16_t* Ub = L + L0_UB; const bf16_t* Gb = L + L0_GB;
  bf16_t* cat = (bf16_t*)(P.ws + OFF_CAT);
  const size_t tb = (size_t)b * S;
  __syncthreads();
  for (int c = tid; c < 62 * 64; c += NTHR) {
    const int row = c >> 6, cc = c & 63; const int s = s0 - 15 + row;
    uint4 o = make_uint4(0, 0, 0, 0);
    if (s >= 0 && s < S) {
      uint4 a = *(const uint4*)(Ua + (tb + s) * 512 + cc * 8), bb = *(const uint4*)(Ub + (tb + s) * 512 + cc * 8);
      o.x = pk2(bflo(a.x) * sigmoidf_(bflo(bb.x)), bfhi(a.x) * sigmoidf_(bfhi(bb.x)));
      o.y = pk2(bflo(a.y) * sigmoidf_(bflo(bb.y)), bfhi(a.y) * sigmoidf_(bfhi(bb.y)));
      o.z = pk2(bflo(a.z) * sigmoidf_(bflo(bb.z)), bfhi(a.z) * sigmoidf_(bfhi(bb.z)));
      o.w = pk2(bflo(a.w) * sigmoidf_(bflo(bb.w)), bfhi(a.w) * sigmoidf_(bfhi(bb.w)));
    }
    *(uint4*)(smem + row * 512 + cc * 8) = o;
  }
  __syncthreads();
  {
    float wx[31], wy[31];
#pragma unroll
    for (int j = 0; j < 31; j++) { float2 v = *(const float2*)(P.dw_w + j * 512 + 2 * tid); wx[j] = v.x; wy[j] = v.y; }
    const float2 bias = *(const float2*)(P.dw_b + 2 * tid);
    unsigned* su = (unsigned*)smem;
    for (int tg = 0; tg < 4; tg++) {
      float ax[8], ay[8];
#pragma unroll
      for (int k = 0; k < 8; k++) { ax[k] = bias.x; ay[k] = bias.y; }
#pragma unroll
      for (int rr = 0; rr < 38; rr++) {
        const unsigned u = su[(tg * 8 + rr) * 256 + tid];
        const float vx = bflo(u), vy = bfhi(u);
#pragma unroll
        for (int k = 0; k < 8; k++) {
          const int j = rr - k;
          if (j >= 0 && j <= 30) { ax[k] += vx * wx[j]; ay[k] += vy * wy[j]; }
        }
      }
#pragma unroll
      for (int k = 0; k < 8; k++) su[(tg * 8 + k) * 256 + tid] = pk2(ax[k], ay[k]);
    }
  }
  __syncthreads();
  for (int k = 0; k < 8; k++) {
    const int tl = w * 8 + k;
    uint4 u = *(const uint4*)(smem + tl * 512 + lane * 8);
    float v[8] = {bflo(u.x), bfhi(u.x), bflo(u.y), bfhi(u.y), bflo(u.z), bfhi(u.z), bflo(u.w), bfhi(u.w)};
    float s1 = 0.f, s2 = 0.f;
#pragma unroll
    for (int j = 0; j < 8; j++) { s1 += v[j]; s2 += v[j] * v[j]; }
    s1 = wave_sum(s1); s2 = wave_sum(s2);
    const float mu = s1 * (1.f / 512.f); float var = s2 * (1.f / 512.f) - mu * mu; var = var < 0.f ? 0.f : var;
    const float rstd = rsqrtf(var + EPS);
    const size_t tq = tb + s0 + tl;
    const uint4 gu = *(const uint4*)(Gb + tq * 512 + lane * 8);
    const float gg[8] = {bflo(gu.x), bfhi(gu.x), bflo(gu.y), bfhi(gu.y), bflo(gu.z), bfhi(gu.z), bflo(gu.w), bfhi(gu.w)};
    const float4 lg0 = *(const float4*)(P.cln_g + lane * 8), lg1 = *(const float4*)(P.cln_g + lane * 8 + 4);
    const float4 lb0 = *(const float4*)(P.cln_b + lane * 8), lb1 = *(const float4*)(P.cln_b + lane * 8 + 4);
    const float lg[8] = {lg0.x, lg0.y, lg0.z, lg0.w, lg1.x, lg1.y, lg1.z, lg1.w};
    const float lb[8] = {lb0.x, lb0.y, lb0.z, lb0.w, lb1.x, lb1.y, lb1.z, lb1.w};
    float ov[8];
#pragma unroll
    for (int j = 0; j < 8; j++) { float y = (v[j] - mu) * rstd * lg[j] + lb[j]; ov[j] = siluf_(y) * siluf_(gg[j]); }
    *(uint4*)(cat + tq * 1024 + 512 + lane * 8) = make_uint4(pk2(ov[0], ov[1]), pk2(ov[2], ov[3]), pk2(ov[4], ov[5]), pk2(ov[6], ov[7]));
  }
}

DI void ph_mix_e(const Params& P, int g, bf16_t* smem) {
  const int nconv = TOK / 32, nna = 8192;
  for (int it = obid(); it < nconv + nna; it += gridDim.x) {
    if (it < nconv) conv_item(P, g, it, smem); else na_item(P, g, it - nconv, smem);
  }
}

DI void ph_out(const Params& P, int layer, bf16_t* smem) {
  WAVE_IDS
  const bf16_t* cat = (const bf16_t*)(P.ws + OFF_CAT);
  const bf16_t* W = (const bf16_t*)(P.ws + (layer ? OFF_WOUTO : OFF_WOUTE));
  bf16_t* ob = (bf16_t*)(P.ws + OFF_L) + (layer ? L1_OB : L0_OB);
  float* ss = (float*)(P.ws + OFF_SS);
  for (int it = 0;; it++) {
    int mt, nt; if (!tile_sched(bid, it, 8, 8, mt, nt)) break;
    const int m0 = mt * 128, n0 = nt * 128;
    __syncthreads();
    f32x16 acc[2][2]; ZERO_ACC(acc)
    LoadBf16 la{cat + (size_t)m0 * 1024, 1024}; LoadBf16 lb{W + (size_t)n0 * 1024, 1024};
    gemm_core(la, lb, 16, smem, acc, true);
#pragma unroll
    for (int j = 0; j < 2; j++) {
      const int tl = wn * 64 + j * 32 + l32; const size_t tg = (size_t)m0 + tl;
      float sq = 0.f;
#pragma unroll
      for (int i = 0; i < 2; i++)
#pragma unroll
        for (int rq = 0; rq < 4; rq++) {
          const int c = n0 + wm * 64 + i * 32 + 8 * rq + 4 * h;
          const float a0 = acc[i][j][4 * rq], a1 = acc[i][j][4 * rq + 1], a2 = acc[i][j][4 * rq + 2], a3 = acc[i][j][4 * rq + 3];
          sq += a0 * a0 + a1 * a1 + a2 * a2 + a3 * a3;
          store4(ob + tg * 1024 + c, a0, a1, a2, a3);
        }
      sq += __shfl_xor(sq, 32);
      if (h == 0) ss[tg * 16 + nt * 2 + wm] = sq;
    }
  }
}

DI void ph_resid(const Params& P, int g, int layer) {
  const int tid0 = otid(); const int lane = tid0 & 63;
  const int wid = (obid() * NTHR + tid0) >> 6, nw = (gridDim.x * NTHR) >> 6;
  const float* xs = layer ? (g ? P.y1 : P.y0) : (g ? P.x1 : P.x0);
  float* y = g ? P.y1 : P.y0;
  const bf16_t* ob = (const bf16_t*)(P.ws + OFF_L) + (layer ? L1_OB : L0_OB);
  bf16_t* x1b = (bf16_t*)(P.ws + OFF_L) + (layer ? L1_X1B : L0_X1B);
  const float* ss = (const float*)(P.ws + OFF_SS);
  const float* gp = P.g_post + layer * 1024;
  for (int t = wid; t < TOK; t += nw) {
    float s = (lane < 16) ? ss[(size_t)t * 16 + lane] : 0.f;
    s = wave_sum(s);
    const float rs = rsqrtf(s * (1.f / 1024.f) + EPS);
#pragma unroll
    for (int k = 0; k < 4; k++) {
      const int f = (k * 64 + lane) * 4;
      const float4 xv = *(const float4*)(xs + (size_t)t * 1024 + f);
      const uint2 ou = *(const uint2*)(ob + (size_t)t * 1024 + f);
      const float4 gv = *(const float4*)(gp + f);
      float4 r;
      r.x = xv.x + bflo(ou.x) * rs * gv.x; r.y = xv.y + bfhi(ou.x) * rs * gv.y;
      r.z = xv.z + bflo(ou.y) * rs * gv.z; r.w = xv.w + bfhi(ou.y) * rs * gv.w;
      *(float4*)(y + (size_t)t * 1024 + f) = r;
      store4(x1b + (size_t)t * 1024 + f, r.x, r.y, r.z, r.w);
    }
  }
}

DI void ph_ple(const Params& P, int g, int layer, bf16_t* smem) {
  WAVE_IDS
  const bf16_t* x1b = (const bf16_t*)(P.ws + OFF_L) + (layer ? L1_X1B : L0_X1B);
  const bf16_t* Wg = (const bf16_t*)(P.ws + (layer ? OFF_WG1 : OFF_WG0));
  const bf16_t* We = (const bf16_t*)(P.ws + (layer ? OFF_WE1 : OFF_WE0));
  const float* pp = (g ? P.p1 : P.p0) + (size_t)layer * TOK * 256;
  float* y = g ? P.y1 : P.y0;
  bf16_t* x2b = (bf16_t*)(P.ws + OFF_X2B);
  float* ssx = (float*)(P.ws + OFF_SSX);
  for (int it = 0;; it++) {
    int mt, nt; if (!tile_sched(bid, it, 8, 8, mt, nt)) break;
    const int m0 = mt * 128, n0 = nt * 128;
    __syncthreads();
    f32x16 acc[2][2]; ZERO_ACC(acc)
    { LoadF32 la{pp + (size_t)m0 * 256, 256}; LoadBf16 lb{We + (size_t)n0 * 256, 256}; gemm_core(la, lb, 4, smem, acc, true); }
    unsigned ep[2][2][8];
#pragma unroll
    for (int i = 0; i < 2; i++)
#pragma unroll
      for (int j = 0; j < 2; j++)
#pragma unroll
        for (int r = 0; r < 8; r++) { ep[i][j][r] = pk2(acc[i][j][2 * r], acc[i][j][2 * r + 1]); }
    ZERO_ACC(acc)
    { LoadBf16 la{x1b + (size_t)m0 * 1024, 1024}; LoadBf16 lb{Wg + (size_t)n0 * 1024, 1024}; gemm_core(la, lb, 16, smem, acc, true); }
#pragma unroll
    for (int j = 0; j < 2; j++) {
      const int tl = wn * 64 + j * 32 + l32; const size_t tg = (size_t)m0 + tl;
      float sq = 0.f;
#pragma unroll
      for (int i = 0; i < 2; i++)
#pragma unroll
        for (int rq = 0; rq < 4; rq++) {
          const int c = n0 + wm * 64 + i * 32 + 8 * rq + 4 * h;
          float4 xv = *(const float4*)(y + tg * 1024 + c);
          xv.x += sigmoidf_(acc[i][j][4 * rq]) * bflo(ep[i][j][2 * rq]); xv.y += sigmoidf_(acc[i][j][4 * rq + 1]) * bfhi(ep[i][j][2 * rq]);
          xv.z += sigmoidf_(acc[i][j][4 * rq + 2]) * bflo(ep[i][j][2 * rq + 1]); xv.w += sigmoidf_(acc[i][j][4 * rq + 3]) * bfhi(ep[i][j][2 * rq + 1]);
          *(float4*)(y + tg * 1024 + c) = xv;
          if (layer == 0) {
            sq += xv.x * xv.x + xv.y * xv.y + xv.z * xv.z + xv.w * xv.w;
            store4(x2b + tg * 1024 + c, xv.x, xv.y, xv.z, xv.w);
          }
        }
      if (layer == 0) {
        sq += __shfl_xor(sq, 32);
        if (h == 0) ssx[tg * 16 + nt * 2 + wm] = sq;
      }
    }
  }
}

DI void ph_in_o(const Params& P, int g, bf16_t* smem, float* s_rs) {
  WAVE_IDS
  const int S = g ? 4096 : 8192;
  const bf16_t* x2b = (const bf16_t*)(P.ws + OFF_X2B);
  const float* ssx = (const float*)(P.ws + OFF_SSX);
  const bf16_t* W = (const bf16_t*)(P.ws + OFF_WINO);
  bf16_t* L = (bf16_t*)(P.ws + OFF_L);
  float* ssq = (float*)(P.ws + OFF_SSQ); float* sskv = (float*)(P.ws + OFF_SSKV);
  const float* ropec = (const float*)(P.ws + OFF_ROPEC); const float* ropes = (const float*)(P.ws + OFF_ROPES);
  for (int it = 0;; it++) {
    int mt, nt; if (!tile_sched(bid, it, 20, 10, mt, nt)) break;
    const int m0 = mt * 128, n0 = nt * 128;
    __syncthreads();
    if (tid < 128) {
      const float4* pp = (const float4*)(ssx + (size_t)(m0 + tid) * 16);
      float4 a = pp[0], b = pp[1], c = pp[2], d = pp[3];
      float s = a.x + a.y + a.z + a.w + b.x + b.y + b.z + b.w + c.x + c.y + c.z + c.w + d.x + d.y + d.z + d.w;
      s_rs[tid] = rsqrtf(s * (1.f / 1024.f) + EPS);
    }
    f32x16 acc[2][2]; ZERO_ACC(acc)
    LoadBf16 la{x2b + (size_t)m0 * 1024, 1024}; LoadBf16 lb{W + (size_t)n0 * 1024, 1024};
    const bool isY = (nt >= 8 && nt < 16);
    gemm_core(la, lb, 16, smem, acc, !isY);
    if (isY) {
      bf16_t* Yt = L + L1_YT;
#pragma unroll
      for (int j = 0; j < 2; j++) {
        const int f = (nt - 8) * 128 + wn * 64 + j * 32 + l32;
#pragma unroll
        for (int i = 0; i < 2; i++)
#pragma unroll
          for (int rq = 0; rq < 4; rq++) {
            const int tl = wm * 64 + i * 32 + 8 * rq + 4 * h; const int tg = m0 + tl; const int b = tg / S, s = tg % S;
            store4(Yt + ((size_t)b * 1024 + f) * S + s, acc[i][j][4 * rq] * s_rs[tl], acc[i][j][4 * rq + 1] * s_rs[tl + 1],
                   acc[i][j][4 * rq + 2] * s_rs[tl + 2], acc[i][j][4 * rq + 3] * s_rs[tl + 3]);
          }
      }
    } else if (nt == 3) {
      bf16_t* kr = L + L1_KR;
      if (wm == 0) {
#pragma unroll
        for (int j = 0; j < 2; j++) {
          const int tl = wn * 64 + j * 32 + l32; const size_t tg = (size_t)m0 + tl; const float rs = s_rs[tl];
          const int pos = (int)(tg % S);
#pragma unroll
          for (int rq = 0; rq < 2; rq++) {
            const int fi = 8 * rq + 4 * h;
            const float4 cv = *(const float4*)(ropec + pos * 16 + fi), sv = *(const float4*)(ropes + pos * 16 + fi);
            const float a0 = acc[0][j][4 * rq] * rs, a1 = acc[0][j][4 * rq + 1] * rs, a2 = acc[0][j][4 * rq + 2] * rs, a3 = acc[0][j][4 * rq + 3] * rs;
            const float b0 = acc[0][j][4 * rq + 8] * rs, b1 = acc[0][j][4 * rq + 9] * rs, b2 = acc[0][j][4 * rq + 10] * rs, b3 = acc[0][j][4 * rq + 11] * rs;
            store4(kr + tg * 32 + fi, a0 * cv.x - b0 * sv.x, a1 * cv.y - b1 * sv.y, a2 * cv.z - b2 * sv.z, a3 * cv.w - b3 * sv.w);
            store4(kr + tg * 32 + 16 + fi, b0 * cv.x + a0 * sv.x, b1 * cv.y + a1 * sv.y, b2 * cv.z + a2 * sv.z, b3 * cv.w + a3 * sv.w);
          }
        }
      }
    } else {
      bf16_t* dst; int ldd, cin;
      if (nt < 2) { dst = L + L1_CQ; ldd = 256; cin = nt * 128; }
      else if (nt == 2) { dst = L + L1_CKV; ldd = 128; cin = 0; }
      else if (nt < 8) { dst = L + L1_GC; ldd = 512; cin = (nt - 4) * 128; }
      else { dst = L + L1_GD; ldd = 512; cin = (nt - 16) * 128; }
#pragma unroll
      for (int j = 0; j < 2; j++) {
        const int tl = wn * 64 + j * 32 + l32; const size_t tg = (size_t)m0 + tl; const float rs = s_rs[tl];
        float sq = 0.f;
#pragma unroll
        for (int i = 0; i < 2; i++)
#pragma unroll
          for (int rq = 0; rq < 4; rq++) {
            const int c = cin + wm * 64 + i * 32 + 8 * rq + 4 * h;
            const float a0 = acc[i][j][4 * rq] * rs, a1 = acc[i][j][4 * rq + 1] * rs, a2 = acc[i][j][4 * rq + 2] * rs, a3 = acc[i][j][4 * rq + 3] * rs;
            sq += a0 * a0 + a1 * a1 + a2 * a2 + a3 * a3;
            store4(dst + tg * ldd + c, a0, a1, a2, a3);
          }
        if (nt < 3) {
          sq += __shfl_xor(sq, 32);
          if (h == 0) { if (nt < 2) ssq[tg * 4 + nt * 2 + wm] = sq; else sskv[tg * 2 + wm] = sq; }
        }
      }
    }
  }
}

DI void ph_up(const Params& P, int g, bf16_t* smem, float* s_rs) {
  WAVE_IDS
  const int S = g ? 4096 : 8192;
  bf16_t* L = (bf16_t*)(P.ws + OFF_L);
  const bf16_t* cq = L + L1_CQ; const bf16_t* ckv = L + L1_CKV;
  const float* ssq = (const float*)(P.ws + OFF_SSQ); const float* sskv = (const float*)(P.ws + OFF_SSKV);
  const bf16_t* Wuq = (const bf16_t*)(P.ws + OFF_WUQ); const bf16_t* Wukv = (const bf16_t*)(P.ws + OFF_WUKV);
  const float* ropec = (const float*)(P.ws + OFF_ROPEC); const float* ropes = (const float*)(P.ws + OFF_ROPES);
  for (int it = 0;; it++) {
    int mt, nt14; if (!tile_sched(bid, it, 14, 14, mt, nt14)) break;
    const int m0 = mt * 128;
    __syncthreads();
    f32x16 acc[2][2]; ZERO_ACC(acc)
    if (nt14 < 6) {
      const int nt = nt14, n0 = nt * 128;
      if (tid < 128) { const float4 a = *(const float4*)(ssq + (size_t)(m0 + tid) * 4); s_rs[tid] = rsqrtf((a.x + a.y + a.z + a.w) * (1.f / 256.f) + EPS); }
      LoadBf16 la{cq + (size_t)m0 * 256, 256}; LoadBf16 lb{Wuq + (size_t)n0 * 256, 256};
      gemm_core(la, lb, 4, smem, acc, true);
      bf16_t* Qm = L + L1_QM;
#pragma unroll
      for (int j = 0; j < 2; j++) {
        const int tl = wn * 64 + j * 32 + l32; const size_t tg = (size_t)m0 + tl; const float rs = s_rs[tl];
        const int pos = (int)(tg % S);
#pragma unroll
        for (int i = 0; i < 2; i++) {
          const int f0 = n0 + wm * 64 + i * 32;
          if ((f0 % 96) == 64) {
#pragma unroll
            for (int rq = 0; rq < 2; rq++) {
              const int fi = 8 * rq + 4 * h;
              const float4 cv = *(const float4*)(ropec + pos * 16 + fi), sv = *(const float4*)(ropes + pos * 16 + fi);
              const float a0 = acc[i][j][4 * rq] * rs, a1 = acc[i][j][4 * rq + 1] * rs, a2 = acc[i][j][4 * rq + 2] * rs, a3 = acc[i][j][4 * rq + 3] * rs;
              const float b0 = acc[i][j][4 * rq + 8] * rs, b1 = acc[i][j][4 * rq + 9] * rs, b2 = acc[i][j][4 * rq + 10] * rs, b3 = acc[i][j][4 * rq + 11] * rs;
              store4(Qm + tg * 768 + f0 + fi, a0 * cv.x - b0 * sv.x, a1 * cv.y - b1 * sv.y, a2 * cv.z - b2 * sv.z, a3 * cv.w - b3 * sv.w);
              store4(Qm + tg * 768 + f0 + 16 + fi, b0 * cv.x + a0 * sv.x, b1 * cv.y + a1 * sv.y, b2 * cv.z + a2 * sv.z, b3 * cv.w + a3 * sv.w);
            }
          } else {
#pragma unroll
            for (int rq = 0; rq < 4; rq++)
              store4(Qm + tg * 768 + f0 + 8 * rq + 4 * h, acc[i][j][4 * rq] * rs, acc[i][j][4 * rq + 1] * rs, acc[i][j][4 * rq + 2] * rs, acc[i][j][4 * rq + 3] * rs);
          }
        }
      }
    } else {
      const int nt = nt14 - 6, n0 = nt * 128;
      if (tid < 128) { const float2 a = *(const float2*)(sskv + (size_t)(m0 + tid) * 2); s_rs[tid] = rsqrtf((a.x + a.y) * (1.f / 128.f) + EPS); }
      LoadBf16 la{ckv + (size_t)m0 * 128, 128}; LoadBf16 lb{Wukv + (size_t)n0 * 128, 128};
      const bool swap = nt < 4;
      gemm_core(la, lb, 2, smem, acc, swap);
      if (swap) {
        bf16_t* Kn = L + L1_KN;
#pragma unroll
        for (int j = 0; j < 2; j++) {
          const int tl = wn * 64 + j * 32 + l32; const size_t tg = (size_t)m0 + tl; const float rs = s_rs[tl];
#pragma unroll
          for (int i = 0; i < 2; i++)
#pragma unroll
            for (int rq = 0; rq < 4; rq++)
              store4(Kn + tg * 512 + n0 + wm * 64 + i * 32 + 8 * rq + 4 * h, acc[i][j][4 * rq] * rs, acc[i][j][4 * rq + 1] * rs, acc[i][j][4 * rq + 2] * rs, acc[i][j][4 * rq + 3] * rs);
        }
      } else {
        bf16_t* Vt = L + L1_VT;
#pragma unroll
        for (int j = 0; j < 2; j++) {
          const int c = (nt - 4) * 128 + wn * 64 + j * 32 + l32; const int hh = c >> 6, d = c & 63;
#pragma unroll
          for (int i = 0; i < 2; i++)
#pragma unroll
            for (int rq = 0; rq < 4; rq++) {
              const int tl = wm * 64 + i * 32 + 8 * rq + 4 * h; const int tg = m0 + tl; const int b = tg / S, s = tg % S;
              store4(Vt + ((size_t)(b * 8 + hh) * 64 + d) * S + s, acc[i][j][4 * rq] * s_rs[tl], acc[i][j][4 * rq + 1] * s_rs[tl + 1],
                     acc[i][j][4 * rq + 2] * s_rs[tl + 2], acc[i][j][4 * rq + 3] * s_rs[tl + 3]);
            }
        }
      }
    }
  }
}

constexpr int KLD = 104, VLD = 72;
constexpr int ATT_STAGE_E = 64 * KLD + 64 * VLD;
DI void mla_item(const Params& P, int g, int item, bf16_t* smem) {
  WAVE_IDS
  const int S = g ? 4096 : 8192;
  const int nqt = S >> 7;
  const int qt = item % nqt; const int bh = item / nqt; const int hh = bh & 7, b = bh >> 3;
  const bf16_t* L = (const bf16_t*)(P.ws + OFF_L);
  const bf16_t* Qm = L + L1_QM; const bf16_t* Kn = L + L1_KN; const bf16_t* Vt = L + L1_VT; const bf16_t* Kr = L + L1_KR; const bf16_t* Gc = L + L1_GC;
  bf16_t* cat = (bf16_t*)(P.ws + OFF_CAT);
  const size_t tb = (size_t)b * S;
  const size_t tq = tb + qt * 128 + w * 32 + l32;
  bf16x8 qf[6];
#pragma unroll
  for (int kk = 0; kk < 6; kk++) qf[kk] = *(const bf16x8*)(Qm + tq * 768 + hh * 96 + kk * 16 + h * 8);
  f32x16 o[2];
#pragma unroll
  for (int i = 0; i < 2; i++)
#pragma unroll
    for (int r = 0; r < 16; r++) o[i][r] = 0.f;
  float m = -1e30f, lsum = 0.f;
  uint4 rk0, rk1, rk2, rv0, rv1;
  const bf16_t* vbase = Vt + (size_t)(b * 8 + hh) * 64 * S;
  const int kc0 = tid, kc1 = tid + 256, kc2 = tid + 512;
  const int kr0 = kc0 / 12, kq0 = kc0 % 12, kr1 = kc1 / 12, kq1 = kc1 % 12, kr2 = kc2 / 12, kq2 = kc2 % 12;
  const int vr0 = tid >> 3, vq0 = tid & 7, vr1 = (tid + 256) >> 3;
#define MLA_KSRC(row, q, k0) ((q) < 8 ? (Kn + (tb + (k0) + (row)) * 512 + hh * 64 + (q) * 8) : (Kr + (tb + (k0) + (row)) * 32 + ((q) - 8) * 8))
#define MLA_GLOAD(kt_) { const int k0_ = (kt_) * 64; \
    rk0 = *(const uint4*)MLA_KSRC(kr0, kq0, k0_); rk1 = *(const uint4*)MLA_KSRC(kr1, kq1, k0_); rk2 = *(const uint4*)MLA_KSRC(kr2, kq2, k0_); \
    rv0 = *(const uint4*)(vbase + (size_t)vr0 * S + k0_ + vq0 * 8); rv1 = *(const uint4*)(vbase + (size_t)vr1 * S + k0_ + vq0 * 8); }
#define MLA_LSTORE(buf_) { bf16_t* sK_ = smem + (buf_) * ATT_STAGE_E; bf16_t* sV_ = sK_ + 64 * KLD; \
    *(uint4*)(sK_ + kr0 * KLD + kq0 * 8) = rk0; *(uint4*)(sK_ + kr1 * KLD + kq1 * 8) = rk1; *(uint4*)(sK_ + kr2 * KLD + kq2 * 8) = rk2; \
    *(uint4*)(sV_ + vr0 * VLD + vq0 * 8) = rv0; *(uint4*)(sV_ + vr1 * VLD + vq0 * 8) = rv1; }
  const int nkt = S >> 6;
  __syncthreads();
  MLA_GLOAD(0) MLA_LSTORE(0)
  __syncthreads();
  for (int kt = 0; kt < nkt; kt++) {
    const int cur = kt & 1;
    if (kt + 1 < nkt) MLA_GLOAD(kt + 1)
    const bf16_t* sK = smem + cur * ATT_STAGE_E; const bf16_t* sV = sK + 64 * KLD;
    f32x16 s[2];
#pragma unroll
    for (int i = 0; i < 2; i++)
#pragma unroll
      for (int r = 0; r < 16; r++) s[i][r] = 0.f;
#pragma unroll
    for (int kk = 0; kk < 6; kk++) {
      bf16x8 a0 = *(const bf16x8*)(sK + l32 * KLD + kk * 16 + h * 8);
      bf16x8 a1 = *(const bf16x8*)(sK + (32 + l32) * KLD + kk * 16 + h * 8);
      s[0] = MFMA32(a0, qf[kk], s[0]); s[1] = MFMA32(a1, qf[kk], s[1]);
    }
    float mx = -1e30f;
#pragma unroll
    for (int i = 0; i < 2; i++)
#pragma unroll
      for (int r = 0; r < 16; r++) mx = fmaxf(mx, s[i][r]);
    mx = fmaxf(mx, __shfl_xor(mx, 32));
    const float mn = fmaxf(m, mx);
    const float alpha = __builtin_amdgcn_exp2f(m - mn);
    m = mn;
    float ps = 0.f;
#pragma unroll
    for (int i = 0; i < 2; i++)
#pragma unroll
      for (int r = 0; r < 16; r++) { float p = __builtin_amdgcn_exp2f(s[i][r] - mn); s[i][r] = p; ps += p; }
    lsum = lsum * alpha + ps;
#pragma unroll
    for (int i = 0; i < 2; i++)
#pragma unroll
      for (int r = 0; r < 16; r++) o[i][r] *= alpha;
#pragma unroll
    for (int mt2 = 0; mt2 < 2; mt2++)
#pragma unroll
      for (int st = 0; st < 2; st++) {
        const uint4 pu = make_uint4(pk2(s[mt2][8 * st], s[mt2][8 * st + 1]), pk2(s[mt2][8 * st + 2], s[mt2][8 * st + 3]),
                                    pk2(s[mt2][8 * st + 4], s[mt2][8 * st + 5]), pk2(s[mt2][8 * st + 6], s[mt2][8 * st + 7]));
        const bf16x8 pf = __builtin_bit_cast(bf16x8, pu);
        const int kb = mt2 * 32 + 16 * st + 4 * h;
#pragma unroll
        for (int dt = 0; dt < 2; dt++) {
          const bf16_t* vp = sV + (dt * 32 + l32) * VLD + kb;
          const uint2 lo = *(const uint2*)vp, hi = *(const uint2*)(vp + 8);
          const bf16x8 av = __builtin_bit_cast(bf16x8, make_uint4(lo.x, lo.y, hi.x, hi.y));
          o[dt] = MFMA32(av, pf, o[dt]);
        }
      }
    if (kt + 1 < nkt) MLA_LSTORE(cur ^ 1)
    __syncthreads();
  }
  lsum += __shfl_xor(lsum, 32);
  const float inv = 1.f / lsum;
#pragma unroll
  for (int dt = 0; dt < 2; dt++)
#pragma unroll
    for (int rq = 0; rq < 4; rq++) {
      const int dv = hh * 64 + dt * 32 + 8 * rq + 4 * h;
      const uint2 gu = *(const uint2*)(Gc + tq * 512 + dv);
      store4(cat + tq * 1024 + dv, o[dt][4 * rq] * inv * siluf_(bflo(gu.x)), o[dt][4 * rq + 1] * inv * siluf_(bfhi(gu.x)),
             o[dt][4 * rq + 2] * inv * siluf_(bflo(gu.y)), o[dt][4 * rq + 3] * inv * siluf_(bfhi(gu.y)));
    }
}

DI void dft_item(const Params& P, int g, int item, bf16_t* smem) {
  WAVE_IDS
  const int S = g ? 4096 : 8192;
  const int mt = item >> 2, ntc = item & 3; const int m0 = mt * 128, n0 = ntc * 128;
  const int b = m0 / S, ks0 = m0 % S;
  const bf16_t* L = (const bf16_t*)(P.ws + OFF_L);
  const bf16_t* Yt = L + L1_YT; const bf16_t* Gd = L + L1_GD;
  bf16_t* cat = (bf16_t*)(P.ws + OFF_CAT);
  __syncthreads();
  f32x16 acc[2][2]; ZERO_ACC(acc)
  LoadDft la; la.ks0 = ks0; la.S = S; la.invS = 1.f / (float)S; la.init(tid);
  LoadYt lb{Yt + ((size_t)b * 1024 + n0) * S, S};
  gemm_core(la, lb, S >> 5, smem, acc, true);
  const float scale = rsqrtf((float)S * 128.f);
#pragma unroll
  for (int j = 0; j < 2; j++) {
    const int tl = wn * 64 + j * 32 + l32; const size_t tg = (size_t)m0 + tl;
#pragma unroll
    for (int i = 0; i < 2; i++)
#pragma unroll
      for (int rq = 0; rq < 4; rq++) {
        const int ch = n0 + wm * 64 + i * 32 + 8 * rq + 4 * h;
        const uint2 gu = *(const uint2*)(Gd + tg * 512 + ch);
        store4(cat + tg * 1024 + 512 + ch, acc[i][j][4 * rq] * scale * siluf_(bflo(gu.x)), acc[i][j][4 * rq + 1] * scale * siluf_(bfhi(gu.x)),
               acc[i][j][4 * rq + 2] * scale * siluf_(bflo(gu.y)), acc[i][j][4 * rq + 3] * scale * siluf_(bfhi(gu.y)));
      }
  }
}

DI void ph_mix_o(const Params& P, int g, bf16_t* smem, int part) {
  const int S = g ? 4096 : 8192; const int B = g ? 16 : 8;
  const int nmla = B * 8 * (S >> 7), ndft = 512 * 4;
  for (int it = obid(); it < nmla + ndft; it += gridDim.x) {
    if (it < nmla) { if (part & 1) mla_item(P, g, it, smem); } else { if (part & 2) dft_item(P, g, it - nmla, smem); }
  }
}

constexpr int NPH = 25;
#ifndef ONLY_SUB
#define ONLY_SUB -1
#endif
#ifndef REP_MASK
#define REP_MASK 0
#endif
DI void run_phase(const Params& P, int ph, bf16_t* smem, float* s_rs, int rep) {
  if (ph == 0) { if (ONLY_SUB < 0 || ONLY_SUB == 99) ph_prelude(P); return; }
  const int g = (ph - 1) / 12; int sub = (ph - 1) % 12 - 1;
  if (ONLY_SUB >= 0) { if (sub != ONLY_SUB) return; sub = ONLY_SUB; }
  switch (sub) {
    case -1: ph_xprep(P, g); break;
    case 0: ph_in_e(P, g, smem, s_rs); break;
    case 1: ph_mix_e(P, g, smem); break;
    case 2: ph_out(P, 0, smem); break;
    case 3: ph_resid(P, g, 0); break;
    case 4: ph_ple(P, g, 0, smem); break;
    case 5: ph_in_o(P, g, smem, s_rs); break;
    case 6: ph_up(P, g, smem, s_rs); break;
    case 7: ph_mix_o(P, g, smem, rep == 0 ? 3 : ((REP_MASK >> 11) & 3)); break;
    case 8: ph_out(P, 1, smem); break;
    case 9: ph_resid(P, g, 1); break;
    default: ph_ple(P, g, 1, smem); break;
  }
}

__global__ void __launch_bounds__(NTHR, 2) mega(Params P, int ph_lo, int ph_hi) {
  __shared__ __attribute__((aligned(16))) bf16_t smem[SMEM_E];
  __shared__ float s_rs[128];
  for (int ph = ph_lo; ph < ph_hi; ph++) {
    const int sub = (ph == 0) ? 31 : ((ph - 1) % 12 == 0 ? 30 : (ph - 1) % 12 - 1);
    const int reps = 1 + ((REP_MASK >> sub) & 1);
    for (int rep = 0; rep < reps; rep++) {
      run_phase(P, ph, smem, s_rs, rep);
      if (ph + 1 < ph_hi || rep + 1 < reps) cg::this_grid().sync();
    }
  }
}

extern "C" void kernel_launch(void* const* d_in, const int* in_sizes, int n_in, void* d_out, int out_size, void* d_ws, size_t ws_size,
                              hipStream_t stream) {
  static int grid_blocks = 0;
  if (!grid_blocks) {
    int dev = 0, cus = 0, per_cu = 0;
    hipGetDevice(&dev);
    hipDeviceGetAttribute(&cus, hipDeviceAttributeMultiprocessorCount, dev);
    hipOccupancyMaxActiveBlocksPerMultiprocessor(&per_cu, mega, NTHR, 0);
    if (per_cu < 1) per_cu = 1;
    if (per_cu > 2) per_cu = 2;
    grid_blocks = cus * per_cu;
  }
  Params P{};
  P.x0 = (const float*)d_in[0]; P.x1 = (const float*)d_in[1]; P.p0 = (const float*)d_in[2]; P.p1 = (const float*)d_in[3];
  P.y0 = (float*)d_out; P.y1 = (float*)d_out + (size_t)TOK * 1024;
  P.g_pre = (const float*)d_in[4]; P.g_post = (const float*)d_in[5]; P.w_ple = (const float*)d_in[6]; P.w_ple_gate = (const float*)d_in[7];
  P.w_in_e = (const float*)d_in[8]; P.rpb = (const float*)d_in[9]; P.dw_w = (const float*)d_in[10]; P.dw_b = (const float*)d_in[11];
  P.cln_g = (const float*)d_in[12]; P.cln_b = (const float*)d_in[13]; P.w_out_e = (const float*)d_in[14]; P.w_in_o = (const float*)d_in[15];
  P.q_norm_g = (const float*)d_in[16]; P.kv_norm_g = (const float*)d_in[17]; P.w_uq = (const float*)d_in[18]; P.w_ukv = (const float*)d_in[19];
  P.w_out_o = (const float*)d_in[20];
  P.ws = (char*)d_ws;
  for (int i = 0; i < 16; i++) P.inv_freq[i] = powf(10000.0f, -(float)(2 * i) / 32.0f);
#if MK_COOP
  int lo = 0, hi = NPH;
  void* args[] = {&P, &lo, &hi};
  hipError_t e = hipLaunchCooperativeKernel((void*)mega, dim3(grid_blocks), dim3(NTHR), args, 0, stream);
  if (e != hipSuccess) fprintf(stderr, "cooperative launch failed: %s (grid %d)\n", hipGetErrorString(e), grid_blocks);
#else
  for (int ph = 0; ph < NPH; ph++) mega<<<dim3(grid_blocks), dim3(NTHR), 0, stream>>>(P, ph, ph + 1);
#endif
}
```

```cpp
#include <hip/hip_runtime.h>
#include <hip/hip_cooperative_groups.h>
#include <cstdio>
#include <cmath>
namespace cg = cooperative_groups;

#ifndef MK_COOP
#define MK_COOP 1
#endif
#ifndef MIXE_REP_PART
#define MIXE_REP_PART 3
#endif

typedef unsigned short bf16_t;
typedef short bf16x8 __attribute__((ext_vector_type(8)));
typedef float f32x16 __attribute__((ext_vector_type(16)));
typedef float f32x4 __attribute__((ext_vector_type(4)));
typedef __bf16 bf16v2 __attribute__((ext_vector_type(2)));
typedef float f32v2 __attribute__((ext_vector_type(2)));
#define DI __device__ __forceinline__
#define MFMA32(a, b, c) __builtin_amdgcn_mfma_f32_32x32x16_bf16((a), (b), (c), 0, 0, 0)
#define MFMA16(a, b, c) __builtin_amdgcn_mfma_f32_16x16x32_bf16((a), (b), (c), 0, 0, 0)

constexpr int TOK = 65536;
constexpr float EPS = 1e-6f;
constexpr float LOG2E = 1.4426950408889634f;
constexpr int NTHR = 256;

constexpr size_t MBy = 1u << 20;
constexpr size_t OFF_WINE = 0;
constexpr size_t OFF_WOUTE = 7 * MBy;
constexpr size_t OFF_WOUTO = 9 * MBy;
constexpr size_t OFF_WG0 = 11 * MBy;
constexpr size_t OFF_WG1 = 13 * MBy;
constexpr size_t OFF_WE0 = 15 * MBy;
constexpr size_t OFF_WE1 = 15 * MBy + 512 * 1024;
constexpr size_t OFF_WINO = 16 * MBy;
constexpr size_t OFF_WUQ = 21 * MBy;
constexpr size_t OFF_WUKV = 21 * MBy + 512 * 1024;
constexpr size_t OFF_ROPEC = 22 * MBy;
constexpr size_t OFF_ROPES = 22 * MBy + 512 * 1024;
constexpr size_t OFF_RSIN = 23 * MBy;
constexpr size_t OFF_SS = 24 * MBy;
constexpr size_t OFF_SSX = 28 * MBy;
constexpr size_t OFF_SSQ = 32 * MBy;
constexpr size_t OFF_SSKV = 33 * MBy;
constexpr size_t OFF_CNT = 33 * MBy + 768 * 1024;
constexpr size_t OFF_BAR = 33 * MBy + 800 * 1024;
constexpr size_t OFF_CAT = 34 * MBy;
constexpr size_t OFF_X2B = 162 * MBy;
constexpr size_t OFF_L = 290 * MBy;
constexpr size_t OFF_XB1 = 824 * MBy;
constexpr size_t OFF_YTF = 952 * MBy;
constexpr size_t ME = 1u << 20;
constexpr size_t L0_Q = 0, L0_K = 32 * ME, L0_VT = 64 * ME, L0_GA = 96 * ME, L0_UA = 128 * ME, L0_UB = 160 * ME, L0_GB = 192 * ME;
constexpr size_t L0_OB = 0, L0_X1B = 128 * ME;
constexpr size_t L1_YT = 0, L1_QM = 64 * ME, L1_KN = 112 * ME, L1_VT = 144 * ME, L1_GC = 176 * ME, L1_GD = 208 * ME,
                 L1_CQ = 240 * ME, L1_CKV = 256 * ME, L1_KR = 264 * ME;
constexpr size_t L1_OB = 0, L1_X1B = 64 * ME;

struct Params {
  const float* x0; const float* x1; const float* p0; const float* p1;
  float* y0; float* y1;
  const float* g_pre; const float* g_post; const float* w_ple; const float* w_ple_gate;
  const float* w_in_e; const float* rpb; const float* dw_w; const float* dw_b; const float* cln_g; const float* cln_b;
  const float* w_out_e; const float* w_in_o; const float* q_norm_g; const float* kv_norm_g;
  const float* w_uq; const float* w_ukv; const float* w_out_o;
  char* ws;
  float inv_freq[16];
};

DI unsigned pk2(float a, float b) { f32v2 v = {a, b}; return __builtin_bit_cast(unsigned, __builtin_convertvector(v, bf16v2)); }
DI float bflo(unsigned u) { return __uint_as_float(u << 16); }
DI float bfhi(unsigned u) { return __uint_as_float(u & 0xffff0000u); }
DI float bf2f_(bf16_t v) { return __uint_as_float((unsigned)v << 16); }
DI float sigmoidf_(float v) { return 1.f / (1.f + __expf(-v)); }
DI float siluf_(float v) { return v / (1.f + __expf(-v)); }
DI void store4(bf16_t* p, float a, float b, float c, float d) { *(uint2*)p = make_uint2(pk2(a, b), pk2(c, d)); }
DI int otid() { int t = threadIdx.x; asm volatile("" : "+v"(t)); return t; }
DI int obid() { int t = blockIdx.x; asm volatile("" : "+s"(t)); return t; }
DI float wave_sum(float s) {
#pragma unroll
  for (int o = 32; o; o >>= 1) s += __shfl_xor(s, o);
  return s;
}

constexpr int LDT = 72;
constexpr int TILE_E = 128 * LDT;
constexpr int SMEM_E = 4 * TILE_E;

struct LoadBf16 {
  static constexpr bool LATE = false;
  const bf16_t* base; int ld;
  DI void pos(int i, int tid, int& row, int& kc) const { int c = tid + 256 * i; row = c >> 3; kc = c & 7; }
  DI uint4 ld1(int kt, int i, int tid) const { int row, kc; pos(i, tid, row, kc); return *(const uint4*)(base + (size_t)row * ld + kt * 64 + kc * 8); }
  DI void load(int kt, int tid, uint4& r0, uint4& r1, uint4& r2, uint4& r3) const { r0 = ld1(kt, 0, tid); r1 = ld1(kt, 1, tid); r2 = ld1(kt, 2, tid); r3 = ld1(kt, 3, tid); }
};
DI size_t tix(size_t t, int f, int KT) { return ((t >> 7) * KT + (f >> 6)) * 8192 + (t & 127) * 64 + (f & 63); }
struct LoadTile {
  static constexpr bool LATE = false;
  const bf16_t* base;
  DI void pos(int i, int tid, int& row, int& kc) const { int c = tid + 256 * i; row = c >> 3; kc = c & 7; }
  DI uint4 ld1(int kt, int i, int tid) const { return *(const uint4*)(base + (size_t)kt * 8192 + (tid + 256 * i) * 8); }
  DI void load(int kt, int tid, uint4& r0, uint4& r1, uint4& r2, uint4& r3) const { r0 = ld1(kt, 0, tid); r1 = ld1(kt, 1, tid); r2 = ld1(kt, 2, tid); r3 = ld1(kt, 3, tid); }
};
struct LoadF32 {
  static constexpr bool LATE = false;
  const float* base; int ld;
  DI void pos(int i, int tid, int& row, int& kc) const { int c = tid + 256 * i; row = c >> 3; kc = c & 7; }
  DI uint4 ld1(int kt, int i, int tid) const {
    int row, kc; pos(i, tid, row, kc);
    const float* s = base + (size_t)row * ld + kt * 64 + kc * 8;
    float4 a = *(const float4*)s, b = *(const float4*)(s + 4);
    return make_uint4(pk2(a.x, a.y), pk2(a.z, a.w), pk2(b.x, b.y), pk2(b.z, b.w));
  }
  DI void load(int kt, int tid, uint4& r0, uint4& r1, uint4& r2, uint4& r3) const { r0 = ld1(kt, 0, tid); r1 = ld1(kt, 1, tid); r2 = ld1(kt, 2, tid); r3 = ld1(kt, 3, tid); }
};
struct LoadYt {
  static constexpr bool LATE = false;
  const bf16_t* base; int S;
  DI void pos(int i, int tid, int& row, int& kc) const { int c = tid + 256 * i; row = c >> 3; kc = c & 7; }
  DI uint4 ld1(int kt, int i, int tid) const { int row, kc; pos(i, tid, row, kc); return *(const uint4*)(base + ((size_t)kt * 1024 + (kc >> 2) * 512 + row) * 32 + (kc & 3) * 8); }
  DI void load(int kt, int tid, uint4& r0, uint4& r1, uint4& r2, uint4& r3) const { r0 = ld1(kt, 0, tid); r1 = ld1(kt, 1, tid); r2 = ld1(kt, 2, tid); r3 = ld1(kt, 3, tid); }
};
struct LoadDft {
  static constexpr bool LATE = true;
  int ks0, S; float invS; float cd0, sd0, cd1, sd1;
  DI void init(int tid) {
    { int row = tid >> 2; float f = (float)(ks0 + row) * invS; cd0 = __builtin_amdgcn_cosf(f); sd0 = __builtin_amdgcn_sinf(f); }
    { int row = (tid + 256) >> 2; float f = (float)(ks0 + row) * invS; cd1 = __builtin_amdgcn_cosf(f); sd1 = __builtin_amdgcn_sinf(f); }
  }
  DI void pos(int i, int tid, int& row, int& kc) const { int q = tid + 256 * (i >> 1); row = q >> 2; kc = (q & 3) + 4 * (i & 1); }
  DI void gen(int kt, int q, float cd, float sd, uint4& rc, uint4& rs) const {
    const int row = q >> 2, seg = q & 3;
    const int ks = ks0 + row; const int sst = kt * 32 + seg * 8;
    const int idx = (ks * sst) & (S - 1);
    const float f = (float)idx * invS;
    const float c0 = __builtin_amdgcn_cosf(f), s0 = __builtin_amdgcn_sinf(f);
    const float c1 = c0 * cd - s0 * sd, s1 = s0 * cd + c0 * sd;
    const float c2 = c1 * cd - s1 * sd, s2 = s1 * cd + c1 * sd;
    const float c3 = c2 * cd - s2 * sd, s3 = s2 * cd + c2 * sd;
    const float c4 = c3 * cd - s3 * sd, s4 = s3 * cd + c3 * sd;
    const float c5 = c4 * cd - s4 * sd, s5 = s4 * cd + c4 * sd;
    const float c6 = c5 * cd - s5 * sd, s6 = s5 * cd + c5 * sd;
    const float c7 = c6 * cd - s6 * sd, s7 = s6 * cd + c6 * sd;
    rc = make_uint4(pk2(c0, c1), pk2(c2, c3), pk2(c4, c5), pk2(c6, c7));
    rs = make_uint4(pk2(-s0, -s1), pk2(-s2, -s3), pk2(-s4, -s5), pk2(-s6, -s7));
  }
  DI void load(int kt, int tid, uint4& r0, uint4& r1, uint4& r2, uint4& r3) const { gen(kt, tid, cd0, sd0, r0, r1); gen(kt, tid + 256, cd1, sd1, r2, r3); }
};

#define GEMM_ST1(sA_, i_, va_, vb_) { int row, kc; la.pos(i_, tid, row, kc); *(uint4*)((sA_) + row * LDT + kc * 8) = va_; \
    lb.pos(i_, tid, row, kc); *(uint4*)((sA_) + TILE_E + row * LDT + kc * 8) = vb_; }
DI void gemm_mma(const bf16_t* sA, f32x16 (&acc)[2][2], const bool swap, int moff, int noff) {
  const bf16_t* sB = sA + TILE_E;
  const bf16_t* sM = swap ? sB : sA; const bf16_t* sN = swap ? sA : sB;
#pragma unroll
  for (int kk = 0; kk < 4; kk++) {
    bf16x8 fm0 = *(const bf16x8*)(sM + moff + kk * 16);
    bf16x8 fm1 = *(const bf16x8*)(sM + moff + 32 * LDT + kk * 16);
    bf16x8 fn0 = *(const bf16x8*)(sN + noff + kk * 16);
    bf16x8 fn1 = *(const bf16x8*)(sN + noff + 32 * LDT + kk * 16);
    acc[0][0] = MFMA32(fm0, fn0, acc[0][0]); acc[0][1] = MFMA32(fm0, fn1, acc[0][1]);
    acc[1][0] = MFMA32(fm1, fn0, acc[1][0]); acc[1][1] = MFMA32(fm1, fn1, acc[1][1]);
  }
}
template <class LA, class LB>
DI void gemm_core(const LA& la, const LB& lb, const int nk, bf16_t* smem, f32x16 (&acc)[2][2], const bool swap) {
  const int tid = otid();
  const int lane = tid & 63, w = tid >> 6, wm = w >> 1, wn = w & 1, l32 = lane & 31, h = lane >> 5;
  uint4 a00, a01, a02, a03, b00, b01, b02, b03, a10, a11, a12, a13, b10, b11, b12, b13;
  const int last = nk - 1;
  la.load(0, tid, a00, a01, a02, a03); lb.load(0, tid, b00, b01, b02, b03);
  { const int k1 = last < 1 ? last : 1; if (!LA::LATE) la.load(k1, tid, a10, a11, a12, a13); lb.load(k1, tid, b10, b11, b12, b13); }
  bf16_t* buf0 = smem; bf16_t* buf1 = smem + 2 * TILE_E;
  GEMM_ST1(buf0, 0, a00, b00) GEMM_ST1(buf0, 1, a01, b01) GEMM_ST1(buf0, 2, a02, b02) GEMM_ST1(buf0, 3, a03, b03)
  __syncthreads();
  const int moff = (wm * 64 + l32) * LDT + h * 8;
  const int noff = (wn * 64 + l32) * LDT + h * 8;
  for (int kt = 0; kt < nk; kt += 2) {
    { const int k2 = (kt + 2 < nk) ? kt + 2 : last; if (!LA::LATE) la.load(k2, tid, a00, a01, a02, a03); lb.load(k2, tid, b00, b01, b02, b03); }
    gemm_mma(buf0, acc, swap, moff, noff);
    if (LA::LATE) la.load(kt + 1, tid, a10, a11, a12, a13);
    GEMM_ST1(buf1, 0, a10, b10) GEMM_ST1(buf1, 1, a11, b11) GEMM_ST1(buf1, 2, a12, b12) GEMM_ST1(buf1, 3, a13, b13)
    __syncthreads();
    { const int k3 = (kt + 3 < nk) ? kt + 3 : last; if (!LA::LATE) la.load(k3, tid, a10, a11, a12, a13); lb.load(k3, tid, b10, b11, b12, b13); }
    gemm_mma(buf1, acc, swap, moff, noff);
    if (LA::LATE) { const int k2 = (kt + 2 < nk) ? kt + 2 : last; la.load(k2, tid, a00, a01, a02, a03); }
    GEMM_ST1(buf0, 0, a00, b00) GEMM_ST1(buf0, 1, a01, b01) GEMM_ST1(buf0, 2, a02, b02) GEMM_ST1(buf0, 3, a03, b03)
    __syncthreads();
  }
}

struct WFrag { bf16x8 f[2][4]; };
template <bool swap, class LA>
DI void gemm_core_ws(const LA& la, const bf16_t* Wt, const int KS, const int nk, bf16_t* smem, f32x16 (&acc)[2][2]) {
  const int tid = otid();
  const int lane = tid & 63, w = tid >> 6, wm = w >> 1, wn = w & 1, l32 = lane & 31, h = lane >> 5;
  const int fb = swap ? wm : wn, tbk = swap ? wn : wm;
  const bf16_t* wp0 = Wt + ((size_t)(fb * 2) * KS) * 512 + lane * 8;
  const bf16_t* wp1 = wp0 + (size_t)KS * 512;
  uint4 a00, a01, a02, a03, a10, a11, a12, a13;
  bf16x8 w00, w01, w02, w03, w04, w05, w06, w07, w10, w11, w12, w13, w14, w15, w16, w17;
  const int last = nk - 1;
#define WLOAD(kt_, p0, p1, p2, p3, p4, p5, p6, p7) { const bf16_t* q0_ = wp0 + (size_t)(kt_) * 2048; const bf16_t* q1_ = wp1 + (size_t)(kt_) * 2048; \
    p0 = *(const bf16x8*)q0_; p1 = *(const bf16x8*)(q0_ + 512); p2 = *(const bf16x8*)(q0_ + 1024); p3 = *(const bf16x8*)(q0_ + 1536); \
    p4 = *(const bf16x8*)q1_; p5 = *(const bf16x8*)(q1_ + 512); p6 = *(const bf16x8*)(q1_ + 1024); p7 = *(const bf16x8*)(q1_ + 1536); }
#define AST1(sA_, i_, va_) { int row, kc; la.pos(i_, tid, row, kc); *(uint4*)((sA_) + row * LDT + kc * 8) = va_; }
#define WMMA(sA_, p0, p1, p2, p3, p4, p5, p6, p7) { const bf16_t* sp_ = (sA_) + aoff; \
    if (swap) { \
      { bf16x8 t0 = *(const bf16x8*)(sp_), t1 = *(const bf16x8*)(sp_ + 32 * LDT); \
        acc[0][0] = MFMA32(p0, t0, acc[0][0]); acc[0][1] = MFMA32(p0, t1, acc[0][1]); acc[1][0] = MFMA32(p4, t0, acc[1][0]); acc[1][1] = MFMA32(p4, t1, acc[1][1]); } \
      { bf16x8 t0 = *(const bf16x8*)(sp_ + 16), t1 = *(const bf16x8*)(sp_ + 32 * LDT + 16); \
        acc[0][0] = MFMA32(p1, t0, acc[0][0]); acc[0][1] = MFMA32(p1, t1, acc[0][1]); acc[1][0] = MFMA32(p5, t0, acc[1][0]); acc[1][1] = MFMA32(p5, t1, acc[1][1]); } \
      { bf16x8 t0 = *(const bf16x8*)(sp_ + 32), t1 = *(const bf16x8*)(sp_ + 32 * LDT + 32); \
        acc[0][0] = MFMA32(p2, t0, acc[0][0]); acc[0][1] = MFMA32(p2, t1, acc[0][1]); acc[1][0] = MFMA32(p6, t0, acc[1][0]); acc[1][1] = MFMA32(p6, t1, acc[1][1]); } \
      { bf16x8 t0 = *(const bf16x8*)(sp_ + 48), t1 = *(const bf16x8*)(sp_ + 32 * LDT + 48); \
        acc[0][0] = MFMA32(p3, t0, acc[0][0]); acc[0][1] = MFMA32(p3, t1, acc[0][1]); acc[1][0] = MFMA32(p7, t0, acc[1][0]); acc[1][1] = MFMA32(p7, t1, acc[1][1]); } \
    } else { \
      { bf16x8 t0 = *(const bf16x8*)(sp_), t1 = *(const bf16x8*)(sp_ + 32 * LDT); \
        acc[0][0] = MFMA32(t0, p0, acc[0][0]); acc[0][1] = MFMA32(t0, p4, acc[0][1]); acc[1][0] = MFMA32(t1, p0, acc[1][0]); acc[1][1] = MFMA32(t1, p4, acc[1][1]); } \
      { bf16x8 t0 = *(const bf16x8*)(sp_ + 16), t1 = *(const bf16x8*)(sp_ + 32 * LDT + 16); \
        acc[0][0] = MFMA32(t0, p1, acc[0][0]); acc[0][1] = MFMA32(t0, p5, acc[0][1]); acc[1][0] = MFMA32(t1, p1, acc[1][0]); acc[1][1] = MFMA32(t1, p5, acc[1][1]); } \
      { bf16x8 t0 = *(const bf16x8*)(sp_ + 32), t1 = *(const bf16x8*)(sp_ + 32 * LDT + 32); \
        acc[0][0] = MFMA32(t0, p2, acc[0][0]); acc[0][1] = MFMA32(t0, p6, acc[0][1]); acc[1][0] = MFMA32(t1, p2, acc[1][0]); acc[1][1] = MFMA32(t1, p6, acc[1][1]); } \
      { bf16x8 t0 = *(const bf16x8*)(sp_ + 48), t1 = *(const bf16x8*)(sp_ + 32 * LDT + 48); \
        acc[0][0] = MFMA32(t0, p3, acc[0][0]); acc[0][1] = MFMA32(t0, p7, acc[0][1]); acc[1][0] = MFMA32(t1, p3, acc[1][0]); acc[1][1] = MFMA32(t1, p7, acc[1][1]); } \
    } }
  la.load(0, tid, a00, a01, a02, a03);
  WLOAD(0, w00, w01, w02, w03, w04, w05, w06, w07)
  { const int k1 = last < 1 ? last : 1; la.load(k1, tid, a10, a11, a12, a13); WLOAD(k1, w10, w11, w12, w13, w14, w15, w16, w17) }
  bf16_t* buf0 = smem; bf16_t* buf1 = smem + TILE_E;
  AST1(buf0, 0, a00) AST1(buf0, 1, a01) AST1(buf0, 2, a02) AST1(buf0, 3, a03)
  __syncthreads();
  const int aoff = (tbk * 64 + l32) * LDT + h * 8;
  for (int kt = 0; kt < nk; kt += 2) {
    const int k2 = (kt + 2 < nk) ? kt + 2 : last, k3 = (kt + 3 < nk) ? kt + 3 : last;
    la.load(k2, tid, a00, a01, a02, a03);
    WMMA(buf0, w00, w01, w02, w03, w04, w05, w06, w07)
    WLOAD(k2, w00, w01, w02, w03, w04, w05, w06, w07)
    AST1(buf1, 0, a10) AST1(buf1, 1, a11) AST1(buf1, 2, a12) AST1(buf1, 3, a13)
    __syncthreads();
    la.load(k3, tid, a10, a11, a12, a13);
    WMMA(buf1, w10, w11, w12, w13, w14, w15, w16, w17)
    WLOAD(k3, w10, w11, w12, w13, w14, w15, w16, w17)
    AST1(buf0, 0, a00) AST1(buf0, 1, a01) AST1(buf0, 2, a02) AST1(buf0, 3, a03)
    __syncthreads();
  }
}

template <class LA>
DI void gemm_core_w(const LA& la, const bf16_t* Wt, const int KS, const int nk, bf16_t* smem, f32x16 (&acc)[2][2], const bool swap) {
  if (swap) gemm_core_ws<true>(la, Wt, KS, nk, smem, acc); else gemm_core_ws<false>(la, Wt, KS, nk, smem, acc);
}

DI bool tile_sched(int bid, int it, int NT, int PW, int& mt, int& nt) {
  const int x = bid & 7, slot = bid >> 3, nslot = gridDim.x >> 3;
  const int j = slot + it * nslot;
  if (j >= 64 * NT) return false;
  const int ppan = 64 * PW; const int panel = j / ppan, rem = j - panel * ppan;
  const int ml = rem / PW; nt = panel * PW + (rem - ml * PW); mt = x * 64 + ml;
  return true;
}

#define ZERO_ACC(a) { _Pragma("unroll") for (int i_ = 0; i_ < 2; i_++) _Pragma("unroll") for (int j_ = 0; j_ < 2; j_++) _Pragma("unroll") for (int r_ = 0; r_ < 16; r_++) a[i_][j_][r_] = 0.f; }
#define WAVE_IDS const int tid = otid(); const int bid = obid(); (void)bid; const int lane = tid & 63, w = tid >> 6, wm = w >> 1, wn = w & 1, l32 = lane & 31, h = lane >> 5; (void)lane; (void)wm; (void)wn; (void)l32; (void)h;

constexpr int ATILE_E = 256 * LDT;
struct LoadTile256 {
  const bf16_t* base; int half_stride;
  DI uint4 ld1(int kt, int i, int tid) const { return *(const uint4*)(base + (size_t)(i >> 2) * half_stride + (size_t)kt * 8192 + (tid + 256 * (i & 3)) * 8); }
};
struct LoadF32x256 {
  const float* base; int ld;
  DI uint4 ld1(int kt, int i, int tid) const {
    const int c = tid + 256 * i; const int row = c >> 3, kc = c & 7;
    const float* s = base + (size_t)row * ld + kt * 64 + kc * 8;
    float4 a = *(const float4*)s, b = *(const float4*)(s + 4);
    return make_uint4(pk2(a.x, a.y), pk2(a.z, a.w), pk2(b.x, b.y), pk2(b.z, b.w));
  }
};
template <bool swap, class LA>
DI void gemm256_ws(const LA& la, const bf16_t* Wt, const int KS, const int nk, bf16_t* smem, f32x16 (&acc)[8]) {
  const int tid = otid();
  const int lane = tid & 63, w = tid >> 6, wm = w >> 1, wn = w & 1, l32 = lane & 31, h = lane >> 5;
  const int fb = swap ? wm : wn, tbk = swap ? wn : wm;
  const bf16_t* wp0 = Wt + ((size_t)(fb * 2) * KS) * 512 + lane * 8;
  const bf16_t* wp1 = wp0 + (size_t)KS * 512;
  uint4 a0, a1, a2, a3;
  bf16x8 w00, w01, w02, w03, w10, w11, w12, w13;
  const int last = nk - 1;
#define A256_LOADH(kt_, hf_) { a0 = la.ld1(kt_, (hf_) * 4 + 0, tid); a1 = la.ld1(kt_, (hf_) * 4 + 1, tid); a2 = la.ld1(kt_, (hf_) * 4 + 2, tid); a3 = la.ld1(kt_, (hf_) * 4 + 3, tid); }
#define A256_STH(sA_, hf_) { bf16_t* d_ = (sA_) + ((hf_) * 128 + (tid >> 3)) * LDT + (tid & 7) * 8; \
    *(uint4*)(d_) = a0; *(uint4*)(d_ + 32 * LDT) = a1; *(uint4*)(d_ + 64 * LDT) = a2; *(uint4*)(d_ + 96 * LDT) = a3; }
#define W256_LD(kt_, kk_, p0, p1) { p0 = *(const bf16x8*)(wp0 + (size_t)(kt_) * 2048 + (kk_) * 512); p1 = *(const bf16x8*)(wp1 + (size_t)(kt_) * 2048 + (kk_) * 512); }
#define MMA256(kk_, p0, p1) { const bf16_t* q_ = sp + (kk_) * 16; \
    const bf16x8 t0 = *(const bf16x8*)(q_), t1 = *(const bf16x8*)(q_ + 32 * LDT), t2 = *(const bf16x8*)(q_ + 64 * LDT), t3 = *(const bf16x8*)(q_ + 96 * LDT); \
    if (swap) { acc[0] = MFMA32(p0, t0, acc[0]); acc[1] = MFMA32(p0, t1, acc[1]); acc[2] = MFMA32(p0, t2, acc[2]); acc[3] = MFMA32(p0, t3, acc[3]); \
                acc[4] = MFMA32(p1, t0, acc[4]); acc[5] = MFMA32(p1, t1, acc[5]); acc[6] = MFMA32(p1, t2, acc[6]); acc[7] = MFMA32(p1, t3, acc[7]); } \
    else      { acc[0] = MFMA32(t0, p0, acc[0]); acc[1] = MFMA32(t0, p1, acc[1]); acc[2] = MFMA32(t1, p0, acc[2]); acc[3] = MFMA32(t1, p1, acc[3]); \
                acc[4] = MFMA32(t2, p0, acc[4]); acc[5] = MFMA32(t2, p1, acc[5]); acc[6] = MFMA32(t3, p0, acc[6]); acc[7] = MFMA32(t3, p1, acc[7]); } }
  A256_LOADH(0, 0) A256_STH(smem, 0)
  A256_LOADH(0, 1) A256_STH(smem, 1)
  W256_LD(0, 0, w00, w10) W256_LD(0, 1, w01, w11) W256_LD(0, 2, w02, w12) W256_LD(0, 3, w03, w13)
  __syncthreads();
  const int aoff = (tbk * 128 + l32) * LDT + h * 8;
  for (int kt = 0; kt < nk; kt++) {
    const int cur = kt & 1; const int kn = (kt + 1 < nk) ? kt + 1 : last;
    const bf16_t* sp = smem + cur * ATILE_E + aoff;
    bf16_t* nxt = smem + (cur ^ 1) * ATILE_E;
    A256_LOADH(kn, 0)
    MMA256(0, w00, w10) W256_LD(kn, 0, w00, w10)
    MMA256(1, w01, w11) W256_LD(kn, 1, w01, w11)
    A256_STH(nxt, 0)
    A256_LOADH(kn, 1)
    MMA256(2, w02, w12) W256_LD(kn, 2, w02, w12)
    MMA256(3, w03, w13) W256_LD(kn, 3, w03, w13)
    A256_STH(nxt, 1)
    __syncthreads();
  }
}
template <class LA>
DI void gemm256(const LA& la, const bf16_t* Wt, const int KS, const int nk, bf16_t* smem, f32x16 (&acc)[8], const bool swap) {
  if (swap) gemm256_ws<true>(la, Wt, KS, nk, smem, acc); else gemm256_ws<false>(la, Wt, KS, nk, smem, acc);
}
#define ZERO_ACC8(a) { _Pragma("unroll") for (int i_ = 0; i_ < 8; i_++) _Pragma("unroll") for (int r_ = 0; r_ < 16; r_++) a[i_][r_] = 0.f; }
DI bool tile_sched256(int bid, int it, int NT, int PW, int& mt, int& nt) {
  const int x = bid & 7, slot = bid >> 3, nslot = gridDim.x >> 3;
  const int j = slot + it * nslot;
  if (j >= 32 * NT) return false;
  const int ppan = 32 * PW; const int panel = j / ppan, rem = j - panel * ppan;
  const int ml = rem / PW; nt = panel * PW + (rem - ml * PW); mt = x * 32 + ml;
  return true;
}
#define SW_FOR_TOK(j) _Pragma("unroll") for (int j = 0; j < 4; j++)
#define SW_FOR_FEAT(i, rq) _Pragma("unroll") for (int i = 0; i < 2; i++) _Pragma("unroll") for (int rq = 0; rq < 4; rq++)
#define SWV(i, j, e) acc[(i) * 4 + (j)][e]
#define NS_FOR_FEAT(j) _Pragma("unroll") for (int j = 0; j < 2; j++)
#define NS_FOR_TOK(i, rq) _Pragma("unroll") for (int i = 0; i < 4; i++) _Pragma("unroll") for (int rq = 0; rq < 4; rq++)
#define NSV(i, j, e) acc[(i) * 2 + (j)][e]
constexpr int EPLD = 136;
constexpr int TPLD = 264;
#define STAGE_SW(scaled_) SW_FOR_TOK(j) { const int tl_ = wn * 128 + j * 32 + l32; const float rs_ = (scaled_) ? s_rs[tl_] : 1.f; \
    SW_FOR_FEAT(i, rq) { const int c_ = wm * 64 + i * 32 + 8 * rq + 4 * h; \
      *(uint2*)(smem + tl_ * EPLD + c_) = make_uint2(pk2(SWV(i, j, 4 * rq) * rs_, SWV(i, j, 4 * rq + 1) * rs_), pk2(SWV(i, j, 4 * rq + 2) * rs_, SWV(i, j, 4 * rq + 3) * rs_)); } }
#define STAGE_NS() NS_FOR_FEAT(j) { const int c_ = wn * 64 + j * 32 + l32; \
    NS_FOR_TOK(i, rq) { const int tl_ = wm * 128 + i * 32 + 8 * rq + 4 * h; \
      *(uint2*)(smem + c_ * TPLD + tl_) = make_uint2(pk2(NSV(i, j, 4 * rq) * s_rs[tl_], NSV(i, j, 4 * rq + 1) * s_rs[tl_ + 1]), pk2(NSV(i, j, 4 * rq + 2) * s_rs[tl_ + 2], NSV(i, j, 4 * rq + 3) * s_rs[tl_ + 3])); } }
DI void rows_out(const bf16_t* smem, bf16_t* dst, int ldd, int tid) {
#pragma unroll 8
  for (int k = 0; k < 16; k++) { const int c = tid + 256 * k; const int row = c >> 4, ch = c & 15;
    *(uint4*)(dst + (size_t)row * ldd + ch * 8) = *(const uint4*)(smem + row * EPLD + ch * 8); }
}
DI void rows_out_tiled(const bf16_t* smem, bf16_t* buf, size_t t0, int f0, int KT, int tid) {
#pragma unroll 8
  for (int k = 0; k < 16; k++) { const int c = tid + 256 * k; const int ch = c & 7, row = (c >> 3) & 255, fh = c >> 11;
    *(uint4*)(buf + tix(t0 + row, f0 + fh * 64 + ch * 8, KT)) = *(const uint4*)(smem + row * EPLD + fh * 64 + ch * 8); }
}

template <class F>
DI void cvt_task(bf16_t* dst, int N, int K, F f, int gt, int gs) {
  const int nu = N * (K >> 3);
  for (int u = gt; u < nu; u += gs) {
    int n = u % N, kc = u / N; float v[8];
#pragma unroll
    for (int j = 0; j < 8; j++) v[j] = f(kc * 8 + j, n);
    *(uint4*)(dst + (((size_t)(n >> 5) * (K >> 4) + (kc >> 1)) * 64 + (kc & 1) * 32 + (n & 31)) * 8) = make_uint4(pk2(v[0], v[1]), pk2(v[2], v[3]), pk2(v[4], v[5]), pk2(v[6], v[7]));
  }
}

DI void ph_prelude(const Params& P) {
  const int tid0 = otid();
  const int gt = obid() * NTHR + tid0, gs = gridDim.x * NTHR;
  char* ws = P.ws;
  if (gt < 64) ((unsigned*)(ws + OFF_CNT))[gt] = 0u;
  { const float* w = P.w_in_e; const float* gp = P.g_pre;
    cvt_task((bf16_t*)(ws + OFF_WINE), 3584, 1024, [=](int k, int n) { return w[(size_t)k * 3584 + n] * gp[k] * (n < 512 ? 0.125f * LOG2E : 1.f); }, gt, gs); }
  { const float* w = P.w_out_e; cvt_task((bf16_t*)(ws + OFF_WOUTE), 1024, 1024, [=](int k, int n) { return w[(size_t)k * 1024 + n]; }, gt, gs); }
  { const float* w = P.w_out_o; cvt_task((bf16_t*)(ws + OFF_WOUTO), 1024, 1024, [=](int k, int n) { return w[(size_t)k * 1024 + n]; }, gt, gs); }
  { const float* w = P.w_ple_gate; cvt_task((bf16_t*)(ws + OFF_WG0), 1024, 1024, [=](int k, int n) { return w[(size_t)k * 1024 + n]; }, gt, gs); }
  { const float* w = P.w_ple_gate + 1024 * 1024; cvt_task((bf16_t*)(ws + OFF_WG1), 1024, 1024, [=](int k, int n) { return w[(size_t)k * 1024 + n]; }, gt, gs); }
  { const float* w = P.w_ple; cvt_task((bf16_t*)(ws + OFF_WE0), 1024, 256, [=](int k, int n) { return w[(size_t)k * 1024 + n]; }, gt, gs); }
  { const float* w = P.w_ple + 256 * 1024; cvt_task((bf16_t*)(ws + OFF_WE1), 1024, 256, [=](int k, int n) { return w[(size_t)k * 1024 + n]; }, gt, gs); }
  {
    const float* w = P.w_in_o; const float* gp = P.g_pre + 1024;
    cvt_task((bf16_t*)(ws + OFF_WINO), 1024, 1024, [=](int k, int n) {
      int col; if (n < 384) col = n; else if (n < 512) { col = (n < 416) ? n : -1; } else col = 416 + (n - 512);
      return col < 0 ? 0.f : w[(size_t)k * 1952 + col] * gp[k]; }, gt, gs);
    cvt_task((bf16_t*)(ws + OFF_WINO) + (size_t)2048 * 1024, 512, 1024, [=](int k, int n) { return w[(size_t)k * 1952 + 1440 + n] * gp[k]; }, gt, gs);
    bf16_t* dst = (bf16_t*)(ws + OFF_WINO) + (size_t)1024 * 1024;
    for (int u = gt; u < 1024 * 128; u += gs) {
      int nn = u & 1023, kcb = u >> 10; int part = nn >> 9, ch = nn & 511, gi = ch >> 7, kc_ = ch & 127;
      float a[8];
#pragma unroll
      for (int j = 0; j < 8; j++) a[j] = 0.f;
      const float* wp = w + 928 + gi * 128 + (size_t)(kcb * 8) * 1952;
      for (int c = 0; c < 128; c++) {
        float f = (float)((kc_ * c) & 127) * (1.f / 128.f);
        float tr = part ? __builtin_amdgcn_sinf(f) : __builtin_amdgcn_cosf(f);
#pragma unroll
        for (int j = 0; j < 8; j++) a[j] += wp[(size_t)j * 1952 + c] * tr;
      }
#pragma unroll
      for (int j = 0; j < 8; j++) a[j] *= gp[kcb * 8 + j];
      *(uint4*)(dst + (((size_t)(nn >> 5) * 64 + (kcb >> 1)) * 64 + (kcb & 1) * 32 + (nn & 31)) * 8) = make_uint4(pk2(a[0], a[1]), pk2(a[2], a[3]), pk2(a[4], a[5]), pk2(a[6], a[7]));
    }
  }
  { const float* w = P.w_uq; const float* gq = P.q_norm_g; const float sc = 0.10206207261596577f * LOG2E;
    cvt_task((bf16_t*)(ws + OFF_WUQ), 768, 256, [=](int k, int n) { return w[(size_t)k * 768 + n] * gq[k] * sc; }, gt, gs); }
  { const float* w = P.w_ukv; const float* gk = P.kv_norm_g;
    cvt_task((bf16_t*)(ws + OFF_WUKV), 1024, 128, [=](int k, int n) {
      int col = (n < 512) ? ((n >> 6) * 128 + (n & 63)) : (((n - 512) >> 6) * 128 + 64 + (n & 63));
      return w[(size_t)k * 1024 + col] * gk[k]; }, gt, gs); }
  { float* rc = (float*)(ws + OFF_ROPEC); float* rsn = (float*)(ws + OFF_ROPES);
    for (int u = gt; u < 8192 * 16; u += gs) {
      int pos = u >> 4, i = u & 15;
      float fr = P.inv_freq[0];
#pragma unroll
      for (int k = 1; k < 16; k++) fr = (i == k) ? P.inv_freq[k] : fr;
      float ang = (float)pos * fr;
      double t = (double)ang * 0.15915494309189535; t -= floor(t);
      float f = (float)t;
      rc[u] = __builtin_amdgcn_cosf(f); rsn[u] = __builtin_amdgcn_sinf(f);
    } }
}

DI void xprep_rows(const Params& P, int g, int t0, int nrows, int wave, int nwaves, int lane) {
  const float* x = g ? P.x1 : P.x0;
  float* rs = (float*)(P.ws + OFF_RSIN) + g * TOK;
  bf16_t* xb = (bf16_t*)(P.ws + (g ? OFF_XB1 : OFF_X2B));
  for (int r = wave; r < nrows; r += nwaves) {
    const int t = t0 + r;
    const float* xr = x + (size_t)t * 1024;
    float s = 0.f;
#pragma unroll
    for (int k = 0; k < 4; k++) {
      const int f = (k * 64 + lane) * 4;
      float4 v = *(const float4*)(xr + f); s += v.x * v.x + v.y * v.y + v.z * v.z + v.w * v.w;
      store4(xb + tix(t, f, 16), v.x, v.y, v.z, v.w);
    }
    s = wave_sum(s);
    if (lane == 0) rs[t] = rsqrtf(s * (1.f / 1024.f) + EPS);
  }
}
DI void ph_xprep(const Params& P, int g) {
  const int tid0 = otid(); const int bid = obid();
  const int x = bid & 7, slot = bid >> 3, nslot = gridDim.x >> 3;
  xprep_rows(P, g, x * (TOK / 8), TOK / 8, slot * (NTHR >> 6) + (tid0 >> 6), nslot * (NTHR >> 6), tid0 & 63);
}

DI void ph_in_e(const Params& P, int g, bf16_t* smem, float* s_rs) {
  WAVE_IDS
  const int S = g ? 4096 : 8192;
  const bf16_t* xb = (const bf16_t*)(P.ws + (g ? OFF_XB1 : OFF_X2B));
  const float* rs_in = (const float*)(P.ws + OFF_RSIN) + g * TOK;
  const bf16_t* W = (const bf16_t*)(P.ws + OFF_WINE);
  bf16_t* L = (bf16_t*)(P.ws + OFF_L);
  for (int it = 0;; it++) {
    int mt, nt; if (!tile_sched256(bid, it, 28, 7, mt, nt)) break;
    const int m0 = mt * 256, n0 = nt * 128; const int split = nt >> 2, cin = (nt & 3) * 128;
    __syncthreads();
    s_rs[tid] = rs_in[m0 + tid];
    f32x16 acc[8]; ZERO_ACC8(acc)
    LoadTile256 la{xb + (size_t)(2 * mt) * 16 * 8192, 16 * 8192};
    const bool swap = (split != 2);
    gemm256(la, W + (size_t)n0 * 1024, 64, 16, smem, acc, swap);
    if (swap) {
      STAGE_SW(true)
      __syncthreads();
      rows_out(smem, L + (size_t)split * 32 * ME + (size_t)m0 * 512 + cin, 512, tid);
    } else {
      STAGE_NS()
      __syncthreads();
      bf16_t* Vt = L + L0_VT; const int b = m0 / S, s0 = m0 % S;
#pragma unroll 8
      for (int k = 0; k < 16; k++) { const int c = tid + 256 * k; const int q = c & 31, f = c >> 5; const int cc = cin + f;
        *(uint4*)(Vt + ((size_t)(b * 8 + (cc >> 6)) * 64 + (cc & 63)) * S + s0 + q * 8) = *(const uint4*)(smem + f * TPLD + q * 8); }
    }
  }
}

constexpr int RPB_OFF_E = 62 * 512;
DI void na_item(const Params& P, int g, int item, bf16_t* smem) {
  const int tid = otid(), lane = tid & 63, w = tid >> 6, q = lane & 15, gq = lane >> 4;
  const int S = g ? 4096 : 8192; const int rows = S >> 6;
  const int hh = item & 7; const int br = item >> 3; const int r = br % rows, b = br / rows;
  const bf16_t* s_rpb = smem + RPB_OFF_E + hh * 465;
  const bf16_t* L = (const bf16_t*)(P.ws + OFF_L);
  const bf16_t* Qb = L + L0_Q; const bf16_t* Kb = L + L0_K; const bf16_t* Vt = L + L0_VT; const bf16_t* Ga = L + L0_GA;
  bf16_t* cat = (bf16_t*)(P.ws + OFF_CAT);
  int rs_ = r - 4; rs_ = rs_ < 0 ? 0 : rs_; rs_ = rs_ > rows - 8 ? rows - 8 : rs_;
  const int cb = (w == 0) ? 0 : (w == 1) ? 8 : (w == 2) ? 24 : 32;
  const int c = 16 * w + q; int cs = c - 8; cs = cs < 0 ? 0 : cs; cs = cs > 48 ? 48 : cs;
  const size_t tb = (size_t)b * S;
  const bf16_t* qp = Qb + (tb + r * 64 + c) * 512 + hh * 64 + gq * 8;
  const bf16x8 qf0 = *(const bf16x8*)qp, qf1 = *(const bf16x8*)(qp + 32);
  f32x4 sc[8][2];
#pragma unroll
  for (int kr = 0; kr < 8; kr++)
#pragma unroll
    for (int T = 0; T < 2; T++) {
      const bf16_t* kp = Kb + (tb + (rs_ + kr) * 64 + cb + 8 * (q >> 2) + 4 * T + (q & 3)) * 512 + hh * 64 + gq * 8;
      bf16x8 k0 = *(const bf16x8*)kp, k1 = *(const bf16x8*)(kp + 32);
      f32x4 a = {0.f, 0.f, 0.f, 0.f};
      a = MFMA16(k0, qf0, a); a = MFMA16(k1, qf1, a);
      sc[kr][T] = a;
    }
  float mx = -1e30f;
#pragma unroll
  for (int kr = 0; kr < 8; kr++)
#pragma unroll
    for (int T = 0; T < 2; T++)
#pragma unroll
      for (int i = 0; i < 4; i++) {
        const int kc = cb + 8 * gq + 4 * T + i;
        const bool valid = (kc >= cs) && (kc < cs + 16);
        const int dr = rs_ + kr - r + 7, dc = kc - c + 15;
        const float bias = bf2f_(s_rpb[valid ? dr * 31 + dc : 0]);
        const float v = valid ? sc[kr][T][i] + bias : -1e30f;
        sc[kr][T][i] = v; mx = fmaxf(mx, v);
      }
  mx = fmaxf(mx, __shfl_xor(mx, 16)); mx = fmaxf(mx, __shfl_xor(mx, 32));
  float sum = 0.f;
#pragma unroll
  for (int kr = 0; kr < 8; kr++)
#pragma unroll
    for (int T = 0; T < 2; T++)
#pragma unroll
      for (int i = 0; i < 4; i++) { float p = __builtin_amdgcn_exp2f(sc[kr][T][i] - mx); sc[kr][T][i] = p; sum += p; }
  sum += __shfl_xor(sum, 16); sum += __shfl_xor(sum, 32);
  f32x4 o[4];
#pragma unroll
  for (int m = 0; m < 4; m++) o[m] = f32x4{0.f, 0.f, 0.f, 0.f};
#pragma unroll
  for (int kr = 0; kr < 8; kr++) {
    uint4 pu = make_uint4(pk2(sc[kr][0][0], sc[kr][0][1]), pk2(sc[kr][0][2], sc[kr][0][3]), pk2(sc[kr][1][0], sc[kr][1][1]), pk2(sc[kr][1][2], sc[kr][1][3]));
    const bf16x8 pb = __builtin_bit_cast(bf16x8, pu);
#pragma unroll
    for (int m = 0; m < 4; m++) {
      const bf16_t* vp = Vt + ((size_t)(b * 8 + hh) * 64 + m * 16 + q) * S + (rs_ + kr) * 64 + cb + 8 * gq;
      const bf16x8 av = *(const bf16x8*)vp;
      o[m] = MFMA16(av, pb, o[m]);
    }
  }
  const float inv = 1.f / sum;
  const size_t tq = tb + r * 64 + c;
#pragma unroll
  for (int m = 0; m < 4; m++) {
    const int dv = hh * 64 + m * 16 + 4 * gq;
    uint2 gu = *(const uint2*)(Ga + tq * 512 + dv);
    store4(cat + tix(tq, dv, 16), o[m][0] * inv * siluf_(bflo(gu.x)), o[m][1] * inv * siluf_(bfhi(gu.x)),
           o[m][2] * inv * siluf_(bflo(gu.y)), o[m][3] * inv * siluf_(bfhi(gu.y)));
  }
}

DI void conv_item(const Params& P, int g, int item, bf16_t* smem) {
  const int tid = otid(), lane = tid & 63, w = tid >> 6;
  const int S = g ? 4096 : 8192;
  const int t0 = item * 32; const int b = t0 / S, s0 = t0 % S;
  const bf16_t* L = (const bf16_t*)(P.ws + OFF_L);
  const bf16_t* Ua = L + L0_UA; const bf16_t* Ub = L + L0_UB; const bf16_t* Gb = L + L0_GB;
  bf16_t* cat = (bf16_t*)(P.ws + OFF_CAT);
  const size_t tb = (size_t)b * S;
  __syncthreads();
  for (int c0 = tid; c0 < 62 * 64; c0 += 4 * NTHR) {
    uint4 av[4], bv[4];
#pragma unroll
    for (int u = 0; u < 4; u++) {
      const int c = c0 + u * NTHR; const int row = c >> 6, cc = c & 63; const int s = s0 - 15 + row;
      av[u] = make_uint4(0, 0, 0, 0); bv[u] = make_uint4(0, 0, 0, 0);
      if (c < 62 * 64 && s >= 0 && s < S) { av[u] = *(const uint4*)(Ua + (tb + s) * 512 + cc * 8); bv[u] = *(const uint4*)(Ub + (tb + s) * 512 + cc * 8); }
    }
#pragma unroll
    for (int u = 0; u < 4; u++) {
      const int c = c0 + u * NTHR; const int row = c >> 6, cc = c & 63;
      const uint4 a = av[u], bb = bv[u];
      uint4 o;
      o.x = pk2(bflo(a.x) * sigmoidf_(bflo(bb.x)), bfhi(a.x) * sigmoidf_(bfhi(bb.x)));
      o.y = pk2(bflo(a.y) * sigmoidf_(bflo(bb.y)), bfhi(a.y) * sigmoidf_(bfhi(bb.y)));
      o.z = pk2(bflo(a.z) * sigmoidf_(bflo(bb.z)), bfhi(a.z) * sigmoidf_(bfhi(bb.z)));
      o.w = pk2(bflo(a.w) * sigmoidf_(bflo(bb.w)), bfhi(a.w) * sigmoidf_(bfhi(bb.w)));
      if (c < 62 * 64) *(uint4*)(smem + row * 512 + cc * 8) = o;
    }
  }
  __syncthreads();
  {
    float wx[31], wy[31];
#pragma unroll
    for (int j = 0; j < 31; j++) { float2 v = *(const float2*)(P.dw_w + j * 512 + 2 * tid); wx[j] = v.x; wy[j] = v.y; }
    const float2 bias = *(const float2*)(P.dw_b + 2 * tid);
    unsigned* su = (unsigned*)smem;
    for (int tg = 0; tg < 4; tg++) {
      float ax[8], ay[8];
#pragma unroll
      for (int k = 0; k < 8; k++) { ax[k] = bias.x; ay[k] = bias.y; }
#pragma unroll
      for (int rr = 0; rr < 38; rr++) {
        const unsigned u = su[(tg * 8 + rr) * 256 + tid];
        const float vx = bflo(u), vy = bfhi(u);
#pragma unroll
        for (int k = 0; k < 8; k++) {
          const int j = rr - k;
          if (j >= 0 && j <= 30) { ax[k] += vx * wx[j]; ay[k] += vy * wy[j]; }
        }
      }
#pragma unroll
      for (int k = 0; k < 8; k++) su[(tg * 8 + k) * 256 + tid] = pk2(ax[k], ay[k]);
    }
  }
  __syncthreads();
  for (int k = 0; k < 8; k++) {
    const int tl = w * 8 + k;
    uint4 u = *(const uint4*)(smem + tl * 512 + lane * 8);
    float v[8] = {bflo(u.x), bfhi(u.x), bflo(u.y), bfhi(u.y), bflo(u.z), bfhi(u.z), bflo(u.w), bfhi(u.w)};
    float s1 = 0.f, s2 = 0.f;
#pragma unroll
    for (int j = 0; j < 8; j++) { s1 += v[j]; s2 += v[j] * v[j]; }
    s1 = wave_sum(s1); s2 = wave_sum(s2);
    const float mu = s1 * (1.f / 512.f); float var = s2 * (1.f / 512.f) - mu * mu; var = var < 0.f ? 0.f : var;
    const float rstd = rsqrtf(var + EPS);
    const size_t tq = tb + s0 + tl;
    const uint4 gu = *(const uint4*)(Gb + tq * 512 + lane * 8);
    const float gg[8] = {bflo(gu.x), bfhi(gu.x), bflo(gu.y), bfhi(gu.y), bflo(gu.z), bfhi(gu.z), bflo(gu.w), bfhi(gu.w)};
    const float4 lg0 = *(const float4*)(P.cln_g + lane * 8), lg1 = *(const float4*)(P.cln_g + lane * 8 + 4);
    const float4 lb0 = *(const float4*)(P.cln_b + lane * 8), lb1 = *(const float4*)(P.cln_b + lane * 8 + 4);
    const float lg[8] = {lg0.x, lg0.y, lg0.z, lg0.w, lg1.x, lg1.y, lg1.z, lg1.w};
    const float lb[8] = {lb0.x, lb0.y, lb0.z, lb0.w, lb1.x, lb1.y, lb1.z, lb1.w};
    float ov[8];
#pragma unroll
    for (int j = 0; j < 8; j++) { float y = (v[j] - mu) * rstd * lg[j] + lb[j]; ov[j] = siluf_(y) * siluf_(gg[j]); }
    *(uint4*)(cat + tix(tq, 512 + lane * 8, 16)) = make_uint4(pk2(ov[0], ov[1]), pk2(ov[2], ov[3]), pk2(ov[4], ov[5]), pk2(ov[6], ov[7]));
  }
}

DI void ph_mix_e(const Params& P, int g, bf16_t* smem, int* s_item, int rep) {
  const int nconv = TOK / 32, nna = 8192;
  unsigned* word = (unsigned*)(P.ws + OFF_CNT) + 32 + g * 2 + rep;
  const int tid = otid();
  __syncthreads();
  for (int i = tid; i < 8 * 465; i += NTHR) smem[RPB_OFF_E + i] = (bf16_t)(pk2(P.rpb[i] * LOG2E, 0.f) & 0xffffu);
  if (tid == 0) { const unsigned old = atomicAdd(word, 1u); *s_item = (old < (unsigned)(nconv + nna)) ? (int)old : -1; }
  __syncthreads();
  for (;;) {
    const int it = *s_item;
    if (it < 0) break;
    unsigned nxt = 0u;
    if (tid == 0) nxt = atomicAdd(word, 1u);
    const int part = (rep == 0) ? 3 : MIXE_REP_PART;
    if (it < nconv) { if (part & 1) conv_item(P, g, it, smem); } else { if (part & 2) na_item(P, g, it - nconv, smem); }
    __syncthreads();
    if (tid == 0) *s_item = (nxt < (unsigned)(nconv + nna)) ? (int)nxt : -1;
    __syncthreads();
  }
}

DI void ph_out(const Params& P, int layer, bf16_t* smem) {
  WAVE_IDS
  const bf16_t* cat = (const bf16_t*)(P.ws + OFF_CAT);
  const bf16_t* W = (const bf16_t*)(P.ws + (layer ? OFF_WOUTO : OFF_WOUTE));
  bf16_t* ob = (bf16_t*)(P.ws + OFF_L) + (layer ? L1_OB : L0_OB);
  float* ss = (float*)(P.ws + OFF_SS);
  const float* s_rs = nullptr;
  for (int it = 0;; it++) {
    int mt, nt; if (!tile_sched256(bid, it, 8, 8, mt, nt)) break;
    const int m0 = mt * 256, n0 = nt * 128;
    __syncthreads();
    f32x16 acc[8]; ZERO_ACC8(acc)
    LoadTile256 la{cat + (size_t)(2 * mt) * 16 * 8192, 16 * 8192};
    gemm256_ws<true>(la, W + (size_t)n0 * 1024, 64, 16, smem, acc);
    SW_FOR_TOK(j) {
      const int tl = wn * 128 + j * 32 + l32; const size_t tg = (size_t)m0 + tl;
      float sq = 0.f;
      SW_FOR_FEAT(i, rq) {
        const int c = n0 + wm * 64 + i * 32 + 8 * rq + 4 * h;
        const float a0 = SWV(i, j, 4 * rq), a1 = SWV(i, j, 4 * rq + 1), a2 = SWV(i, j, 4 * rq + 2), a3 = SWV(i, j, 4 * rq + 3);
        sq += a0 * a0 + a1 * a1 + a2 * a2 + a3 * a3; (void)c;
      }
      sq += __shfl_xor(sq, 32);
      if (h == 0) ss[tg * 16 + nt * 2 + wm] = sq;
    }
    STAGE_SW(false)
    __syncthreads();
    rows_out(smem, ob + (size_t)m0 * 1024 + n0, 1024, tid);
  }
}

DI void ph_resid(const Params& P, int g, int layer) {
  const int tid0 = otid(); const int lane = tid0 & 63; const int bid = obid();
  const int xq = bid & 7, slot = bid >> 3, nslot = gridDim.x >> 3;
  const int wid = slot * (NTHR >> 6) + (tid0 >> 6), nw = nslot * (NTHR >> 6);
  const int tbeg = xq * (TOK / 8), tend = tbeg + TOK / 8;
  const float* xs = g ? P.x1 : P.x0;
  const bf16_t* x2b = (const bf16_t*)(P.ws + OFF_X2B);
  const bf16_t* ob = (const bf16_t*)(P.ws + OFF_L) + (layer ? L1_OB : L0_OB);
  bf16_t* x1b = (bf16_t*)(P.ws + OFF_L) + (layer ? L1_X1B : L0_X1B);
  const float* ss = (const float*)(P.ws + OFF_SS);
  const float* gp = P.g_post + layer * 1024;
  const float* pp = (g ? P.p1 : P.p0) + (size_t)layer * TOK * 256;
  bf16_t* pb = (bf16_t*)(P.ws + OFF_L) + (layer ? L1_VT : L0_VT);
  for (int t = tbeg + wid; t < tend; t += nw) {
    { const float4 pv = *(const float4*)(pp + (size_t)t * 256 + lane * 4); store4(pb + tix(t, lane * 4, 4), pv.x, pv.y, pv.z, pv.w); }
    float s = (lane < 16) ? ss[(size_t)t * 16 + lane] : 0.f;
    s = wave_sum(s);
    const float rs = rsqrtf(s * (1.f / 1024.f) + EPS);
#pragma unroll
    for (int k = 0; k < 4; k++) {
      const int f = (k * 64 + lane) * 4;
      float4 xv;
      if (layer == 0) xv = *(const float4*)(xs + (size_t)t * 1024 + f);
      else { const uint2 xu = *(const uint2*)(x2b + tix(t, f, 16)); xv = make_float4(bflo(xu.x), bfhi(xu.x), bflo(xu.y), bfhi(xu.y)); }
      const uint2 ou = *(const uint2*)(ob + (size_t)t * 1024 + f);
      const float4 gv = *(const float4*)(gp + f);
      store4(x1b + tix(t, f, 16), xv.x + bflo(ou.x) * rs * gv.x, xv.y + bfhi(ou.x) * rs * gv.y, xv.z + bflo(ou.y) * rs * gv.z, xv.w + bfhi(ou.y) * rs * gv.w);
    }
  }
}

DI void ph_ple(const Params& P, int g, int layer, bf16_t* smem) {
  WAVE_IDS
  const bf16_t* x1b = (const bf16_t*)(P.ws + OFF_L) + (layer ? L1_X1B : L0_X1B);
  const bf16_t* Wg = (const bf16_t*)(P.ws + (layer ? OFF_WG1 : OFF_WG0));
  const bf16_t* We = (const bf16_t*)(P.ws + (layer ? OFF_WE1 : OFF_WE0));
  const bf16_t* pb = (const bf16_t*)(P.ws + OFF_L) + (layer ? L1_VT : L0_VT);
  float* y = g ? P.y1 : P.y0;
  bf16_t* x2b = (bf16_t*)(P.ws + OFF_X2B);
  float* ssx = (float*)(P.ws + OFF_SSX);
  const float* s_rs = nullptr;
  for (int it = 0;; it++) {
    int mt, nt; if (!tile_sched256(bid, it, 8, 8, mt, nt)) break;
    const int m0 = mt * 256, n0 = nt * 128;
    __syncthreads();
    f32x16 acc[8]; ZERO_ACC8(acc)
    { LoadTile256 la{pb + (size_t)(2 * mt) * 4 * 8192, 4 * 8192}; gemm256_ws<true>(la, We + (size_t)n0 * 256, 16, 4, smem, acc); }
    STAGE_SW(false)
    __syncthreads();
    rows_out_tiled(smem, x2b, (size_t)m0, n0, 16, tid);
    __syncthreads();
    ZERO_ACC8(acc)
    { LoadTile256 la{x1b + (size_t)(2 * mt) * 16 * 8192, 16 * 8192}; gemm256_ws<true>(la, Wg + (size_t)n0 * 1024, 64, 16, smem, acc); }
    SW_FOR_TOK(j) { const int tl_ = wn * 128 + j * 32 + l32;
      SW_FOR_FEAT(i, rq) { const int c_ = wm * 64 + i * 32 + 8 * rq + 4 * h;
        *(uint2*)(smem + tl_ * EPLD + c_) = make_uint2(pk2(sigmoidf_(SWV(i, j, 4 * rq)), sigmoidf_(SWV(i, j, 4 * rq + 1))), pk2(sigmoidf_(SWV(i, j, 4 * rq + 2)), sigmoidf_(SWV(i, j, 4 * rq + 3)))); } }
    __syncthreads();
#pragma unroll 8
    for (int k = 0; k < 16; k++) {
      const int c = tid + 256 * k; const int ch8 = c & 7, row = (c >> 3) & 255, fh = c >> 11;
      const int f = fh * 64 + ch8 * 8; const size_t tg = (size_t)m0 + row;
      const uint4 sg = *(const uint4*)(smem + row * EPLD + f);
      bf16_t* ep = x2b + tix(tg, n0 + f, 16);
      const uint4 eu = *(const uint4*)ep;
      float* yp = y + tg * 1024 + n0 + f;
      const uint4 xu = *(const uint4*)(x1b + tix(tg, n0 + f, 16));
      float4 y0 = make_float4(bflo(xu.x), bfhi(xu.x), bflo(xu.y), bfhi(xu.y)), y1 = make_float4(bflo(xu.z), bfhi(xu.z), bflo(xu.w), bfhi(xu.w));
      y0.x += bflo(sg.x) * bflo(eu.x); y0.y += bfhi(sg.x) * bfhi(eu.x); y0.z += bflo(sg.y) * bflo(eu.y); y0.w += bfhi(sg.y) * bfhi(eu.y);
      y1.x += bflo(sg.z) * bflo(eu.z); y1.y += bfhi(sg.z) * bfhi(eu.z); y1.z += bflo(sg.w) * bflo(eu.w); y1.w += bfhi(sg.w) * bfhi(eu.w);
      if (layer != 0) { *(float4*)yp = y0; *(float4*)(yp + 4) = y1; }
      if (layer == 0) {
        *(uint4*)ep = make_uint4(pk2(y0.x, y0.y), pk2(y0.z, y0.w), pk2(y1.x, y1.y), pk2(y1.z, y1.w));
        float sq = y0.x * y0.x + y0.y * y0.y + y0.z * y0.z + y0.w * y0.w + y1.x * y1.x + y1.y * y1.y + y1.z * y1.z + y1.w * y1.w;
        sq += __shfl_xor(sq, 1); sq += __shfl_xor(sq, 2); sq += __shfl_xor(sq, 4);
        if (ch8 == 0) ssx[tg * 16 + nt * 2 + fh] = sq;
      }
    }
  }
}

DI void ph_in_o(const Params& P, int g, bf16_t* smem, float* s_rs) {
  WAVE_IDS
  const int S = g ? 4096 : 8192;
  const bf16_t* x2b = (const bf16_t*)(P.ws + OFF_X2B);
  const float* ssx = (const float*)(P.ws + OFF_SSX);
  const bf16_t* W = (const bf16_t*)(P.ws + OFF_WINO);
  bf16_t* L = (bf16_t*)(P.ws + OFF_L);
  float* ssq = (float*)(P.ws + OFF_SSQ); float* sskv = (float*)(P.ws + OFF_SSKV);
  const float* ropec = (const float*)(P.ws + OFF_ROPEC); const float* ropes = (const float*)(P.ws + OFF_ROPES);
  for (int it = 0;; it++) {
    int mt, nt; if (!tile_sched256(bid, it, 20, 10, mt, nt)) break;
    const int m0 = mt * 256, n0 = nt * 128;
    __syncthreads();
    {
      const float4* pp = (const float4*)(ssx + (size_t)(m0 + tid) * 16);
      float4 a = pp[0], b = pp[1], c = pp[2], d = pp[3];
      float s = a.x + a.y + a.z + a.w + b.x + b.y + b.z + b.w + c.x + c.y + c.z + c.w + d.x + d.y + d.z + d.w;
      s_rs[tid] = rsqrtf(s * (1.f / 1024.f) + EPS);
    }
    f32x16 acc[8]; ZERO_ACC8(acc)
    LoadTile256 la{x2b + (size_t)(2 * mt) * 16 * 8192, 16 * 8192};
    const bool isY = (nt >= 8 && nt < 16);
    gemm256(la, W + (size_t)n0 * 1024, 64, 16, smem, acc, !isY);
    if (isY) {
      bf16_t* Yt = L + L1_YT;
      STAGE_NS()
      __syncthreads();
      const int b = m0 / S, s0 = m0 % S; const int fbase = (nt - 8) * 128;
#pragma unroll 8
      for (int k = 0; k < 16; k++) { const int c = tid + 256 * k; const int q4 = c & 3, f = (c >> 2) & 127, sblk = c >> 9;
        *(uint4*)(Yt + (((size_t)b * (S >> 5) + (s0 >> 5) + sblk) * 1024 + fbase + f) * 32 + q4 * 8) = *(const uint4*)(smem + f * TPLD + sblk * 32 + q4 * 8); }
    } else if (nt == 3) {
      bf16_t* kr = L + L1_KR;
      if (wm == 0) {
        SW_FOR_TOK(j) {
          const int tl = wn * 128 + j * 32 + l32; const size_t tg = (size_t)m0 + tl; const float rs = s_rs[tl];
          const int pos = (int)(tg % S);
#pragma unroll
          for (int rq = 0; rq < 2; rq++) {
            const int fi = 8 * rq + 4 * h;
            const float4 cv = *(const float4*)(ropec + pos * 16 + fi), sv = *(const float4*)(ropes + pos * 16 + fi);
            const float a0 = SWV(0, j, 4 * rq) * rs, a1 = SWV(0, j, 4 * rq + 1) * rs, a2 = SWV(0, j, 4 * rq + 2) * rs, a3 = SWV(0, j, 4 * rq + 3) * rs;
            const float b0 = SWV(0, j, 4 * rq + 8) * rs, b1 = SWV(0, j, 4 * rq + 9) * rs, b2 = SWV(0, j, 4 * rq + 10) * rs, b3 = SWV(0, j, 4 * rq + 11) * rs;
            store4(kr + tg * 32 + fi, a0 * cv.x - b0 * sv.x, a1 * cv.y - b1 * sv.y, a2 * cv.z - b2 * sv.z, a3 * cv.w - b3 * sv.w);
            store4(kr + tg * 32 + 16 + fi, b0 * cv.x + a0 * sv.x, b1 * cv.y + a1 * sv.y, b2 * cv.z + a2 * sv.z, b3 * cv.w + a3 * sv.w);
          }
        }
      }
    } else {
      bf16_t* dst; int ldd, cin;
      if (nt < 2) { dst = L + L1_CQ; ldd = 256; cin = nt * 128; }
      else if (nt == 2) { dst = L + L1_CKV; ldd = 128; cin = 0; }
      else if (nt < 8) { dst = L + L1_GC; ldd = 512; cin = (nt - 4) * 128; }
      else { dst = L + L1_GD; ldd = 512; cin = (nt - 16) * 128; }
      SW_FOR_TOK(j) {
        const int tl = wn * 128 + j * 32 + l32; const size_t tg = (size_t)m0 + tl; const float rs = s_rs[tl];
        float sq = 0.f;
        SW_FOR_FEAT(i, rq) {
          const int c = cin + wm * 64 + i * 32 + 8 * rq + 4 * h;
          const float a0 = SWV(i, j, 4 * rq) * rs, a1 = SWV(i, j, 4 * rq + 1) * rs, a2 = SWV(i, j, 4 * rq + 2) * rs, a3 = SWV(i, j, 4 * rq + 3) * rs;
          sq += a0 * a0 + a1 * a1 + a2 * a2 + a3 * a3; (void)c;
        }
        if (nt < 3) {
          sq += __shfl_xor(sq, 32);
          if (h == 0) { if (nt < 2) ssq[tg * 4 + nt * 2 + wm] = sq; else sskv[tg * 2 + wm] = sq; }
        }
      }
      STAGE_SW(true)
      __syncthreads();
      if (nt < 3) rows_out_tiled(smem, dst, (size_t)m0, cin, ldd >> 6, tid);
      else rows_out(smem, dst + (size_t)m0 * ldd + cin, ldd, tid);
    }
  }
}

DI void yt_fold(const Params& P, int g) {
  const int S = g ? 4096 : 8192; const int B = g ? 16 : 8;
  const bf16_t* Yt = (const bf16_t*)(P.ws + OFF_L) + L1_YT;
  bf16_t* Yf = (bf16_t*)(P.ws + OFF_YTF);
  const int gt = obid() * NTHR + otid(), gs = gridDim.x * NTHR;
  const int nsb = S >> 6;
  const int total = B * nsb * 1024 * 4;
  for (int u = gt; u < total; u += gs) {
    const int seg = u & 3, f = (u >> 2) & 1023; const int sb = (u >> 12) % nsb, b = (u >> 12) / nsb;
    const int s = sb * 32 + seg * 8;
    const bf16_t* yb = Yt + (size_t)b * S * 1024;
    const uint4 own = *(const uint4*)(yb + ((size_t)sb * 1024 + f) * 32 + seg * 8);
    const int pa = S - s - 8;
    const uint4 ca = *(const uint4*)(yb + ((size_t)(pa >> 5) * 1024 + f) * 32 + (pa & 31));
    float p0 = 0.f;
    if (s != 0) { const int pb = S - s; p0 = bf2f_(*(yb + ((size_t)(pb >> 5) * 1024 + f) * 32 + (pb & 31))); }
    const float sg = (f < 512) ? 1.f : -1.f;
    const float o0 = bflo(own.x) + sg * p0,        o1 = bfhi(own.x) + sg * bfhi(ca.w);
    const float o2 = bflo(own.y) + sg * bflo(ca.w), o3 = bfhi(own.y) + sg * bfhi(ca.z);
    const float o4 = bflo(own.z) + sg * bflo(ca.z), o5 = bfhi(own.z) + sg * bfhi(ca.y);
    const float o6 = bflo(own.w) + sg * bflo(ca.y), o7 = bfhi(own.w) + sg * bfhi(ca.x);
    *(uint4*)(Yf + (((size_t)b * nsb + sb) * 1024 + f) * 32 + seg * 8) = make_uint4(pk2(o0, o1), pk2(o2, o3), pk2(o4, o5), pk2(o6, o7));
  }
}

DI void ph_up(const Params& P, int g, bf16_t* smem, float* s_rs) {
  WAVE_IDS
  const int S = g ? 4096 : 8192;
  bf16_t* L = (bf16_t*)(P.ws + OFF_L);
  const bf16_t* cq = L + L1_CQ; const bf16_t* ckv = L + L1_CKV;
  const float* ssq = (const float*)(P.ws + OFF_SSQ); const float* sskv = (const float*)(P.ws + OFF_SSKV);
  const bf16_t* Wuq = (const bf16_t*)(P.ws + OFF_WUQ); const bf16_t* Wukv = (const bf16_t*)(P.ws + OFF_WUKV);
  const float* ropec = (const float*)(P.ws + OFF_ROPEC); const float* ropes = (const float*)(P.ws + OFF_ROPES);
  for (int it = 0;; it++) {
    int mt, nt14; if (!tile_sched(bid, it, 14, 14, mt, nt14)) break;
    const int m0 = mt * 128;
    __syncthreads();
    f32x16 acc[2][2]; ZERO_ACC(acc)
    if (nt14 < 6) {
      const int nt = nt14, n0 = nt * 128;
      if (tid < 128) { const float4 a = *(const float4*)(ssq + (size_t)(m0 + tid) * 4); s_rs[tid] = rsqrtf((a.x + a.y + a.z + a.w) * (1.f / 256.f) + EPS); }
      LoadTile la{cq + (size_t)mt * 4 * 8192};
      gemm_core_w(la, Wuq + (size_t)n0 * 256, 16, 4, smem, acc, true);
      bf16_t* Qm = L + L1_QM;
#pragma unroll
      for (int j = 0; j < 2; j++) {
        const int tl = wn * 64 + j * 32 + l32; const size_t tg = (size_t)m0 + tl; const float rs = s_rs[tl];
        const int pos = (int)(tg % S);
#pragma unroll
        for (int i = 0; i < 2; i++) {
          const int f0 = n0 + wm * 64 + i * 32;
          if ((f0 % 96) == 64) {
#pragma unroll
            for (int rq = 0; rq < 2; rq++) {
              const int fi = 8 * rq + 4 * h;
              const float4 cv = *(const float4*)(ropec + pos * 16 + fi), sv = *(const float4*)(ropes + pos * 16 + fi);
              const float a0 = acc[i][j][4 * rq] * rs, a1 = acc[i][j][4 * rq + 1] * rs, a2 = acc[i][j][4 * rq + 2] * rs, a3 = acc[i][j][4 * rq + 3] * rs;
              const float b0 = acc[i][j][4 * rq + 8] * rs, b1 = acc[i][j][4 * rq + 9] * rs, b2 = acc[i][j][4 * rq + 10] * rs, b3 = acc[i][j][4 * rq + 11] * rs;
              store4(Qm + tg * 768 + f0 + fi, a0 * cv.x - b0 * sv.x, a1 * cv.y - b1 * sv.y, a2 * cv.z - b2 * sv.z, a3 * cv.w - b3 * sv.w);
              store4(Qm + tg * 768 + f0 + 16 + fi, b0 * cv.x + a0 * sv.x, b1 * cv.y + a1 * sv.y, b2 * cv.z + a2 * sv.z, b3 * cv.w + a3 * sv.w);
            }
          } else {
#pragma unroll
            for (int rq = 0; rq < 4; rq++)
              store4(Qm + tg * 768 + f0 + 8 * rq + 4 * h, acc[i][j][4 * rq] * rs, acc[i][j][4 * rq + 1] * rs, acc[i][j][4 * rq + 2] * rs, acc[i][j][4 * rq + 3] * rs);
          }
        }
      }
    } else {
      const int nt = nt14 - 6, n0 = nt * 128;
      if (tid < 128) { const float2 a = *(const float2*)(sskv + (size_t)(m0 + tid) * 2); s_rs[tid] = rsqrtf((a.x + a.y) * (1.f / 128.f) + EPS); }
      LoadTile la{ckv + (size_t)mt * 2 * 8192};
      const bool swap = nt < 4;
      gemm_core_w(la, Wukv + (size_t)n0 * 128, 8, 2, smem, acc, swap);
      if (swap) {
        bf16_t* Kn = L + L1_KN;
#pragma unroll
        for (int j = 0; j < 2; j++) {
          const int tl = wn * 64 + j * 32 + l32; const size_t tg = (size_t)m0 + tl; const float rs = s_rs[tl];
#pragma unroll
          for (int i = 0; i < 2; i++)
#pragma unroll
            for (int rq = 0; rq < 4; rq++)
              store4(Kn + tg * 512 + n0 + wm * 64 + i * 32 + 8 * rq + 4 * h, acc[i][j][4 * rq] * rs, acc[i][j][4 * rq + 1] * rs, acc[i][j][4 * rq + 2] * rs, acc[i][j][4 * rq + 3] * rs);
        }
      } else {
        bf16_t* Vt = L + L1_VT;
#pragma unroll
        for (int j = 0; j < 2; j++) {
          const int c = (nt - 4) * 128 + wn * 64 + j * 32 + l32; const int hh = c >> 6, d = c & 63;
#pragma unroll
          for (int i = 0; i < 2; i++)
#pragma unroll
            for (int rq = 0; rq < 4; rq++) {
              const int tl = wm * 64 + i * 32 + 8 * rq + 4 * h; const int tg = m0 + tl; const int b = tg / S, s = tg % S;
              store4(Vt + ((size_t)(b * 8 + hh) * 64 + d) * S + s, acc[i][j][4 * rq] * s_rs[tl], acc[i][j][4 * rq + 1] * s_rs[tl + 1],
                     acc[i][j][4 * rq + 2] * s_rs[tl + 2], acc[i][j][4 * rq + 3] * s_rs[tl + 3]);
            }
        }
      }
    }
  }
}

constexpr int KLD = 104, VLD = 72;
constexpr int ATT_STAGE_E = 64 * KLD + 64 * VLD;
DI void mla_compute(const bf16_t* sK, const bf16x8 (&qf)[6], f32x16 (&o)[2], f32x16& negm, float& lsum, const bool first, int l32, int h) {
  const bf16_t* sV = sK + 64 * KLD;
  f32x16 s[2];
  const int kp = (l32 & 19) | ((l32 & 4) << 1) | ((l32 & 8) >> 1);
  {
    bf16x8 a0 = *(const bf16x8*)(sK + kp * KLD + h * 8);
    bf16x8 a1 = *(const bf16x8*)(sK + (32 + kp) * KLD + h * 8);
    s[0] = MFMA32(a0, qf[0], negm); s[1] = MFMA32(a1, qf[0], negm);
  }
#pragma unroll
  for (int kk = 1; kk < 6; kk++) {
    bf16x8 a0 = *(const bf16x8*)(sK + kp * KLD + kk * 16 + h * 8);
    bf16x8 a1 = *(const bf16x8*)(sK + (32 + kp) * KLD + kk * 16 + h * 8);
    s[0] = MFMA32(a0, qf[kk], s[0]); s[1] = MFMA32(a1, qf[kk], s[1]);
  }
  float mx = -1e30f;
#pragma unroll
  for (int i = 0; i < 2; i++)
#pragma unroll
    for (int r = 0; r < 16; r++) mx = fmaxf(mx, s[i][r]);
  mx = fmaxf(mx, __shfl_xor(mx, 32));
  if (first || __builtin_amdgcn_ballot_w64(mx > 0.f) != 0ull) {
    const float d = first ? mx : fmaxf(mx, 0.f);
    const float alpha = first ? 0.f : __builtin_amdgcn_exp2f(-d);
#pragma unroll
    for (int i = 0; i < 2; i++)
#pragma unroll
      for (int r = 0; r < 16; r++) { s[i][r] -= d; o[i][r] *= alpha; }
#pragma unroll
    for (int r = 0; r < 16; r++) negm[r] -= d;
    lsum *= alpha;
  }
  float ps = 0.f;
#pragma unroll
  for (int i = 0; i < 2; i++)
#pragma unroll
    for (int r = 0; r < 16; r++) { float p = __builtin_amdgcn_exp2f(s[i][r]); s[i][r] = p; ps += p; }
  lsum += ps;
#pragma unroll
  for (int mt2 = 0; mt2 < 2; mt2++)
#pragma unroll
    for (int st = 0; st < 2; st++) {
      const uint4 pu = make_uint4(pk2(s[mt2][8 * st], s[mt2][8 * st + 1]), pk2(s[mt2][8 * st + 2], s[mt2][8 * st + 3]),
                                  pk2(s[mt2][8 * st + 4], s[mt2][8 * st + 5]), pk2(s[mt2][8 * st + 6], s[mt2][8 * st + 7]));
      const bf16x8 pf = __builtin_bit_cast(bf16x8, pu);
      const int kb = mt2 * 32 + 16 * st + 8 * h;
#pragma unroll
      for (int dt = 0; dt < 2; dt++) {
        const bf16x8 av = *(const bf16x8*)(sV + (dt * 32 + l32) * VLD + kb);
        o[dt] = MFMA32(av, pf, o[dt]);
      }
    }
}
DI void mla_item(const Params& P, int g, int item, bf16_t* smem) {
  WAVE_IDS
  const int S = g ? 4096 : 8192;
  const int nqt = S >> 7;
  const int qt = item % nqt; const int bh = item / nqt; const int hh = bh & 7, b = bh >> 3;
  const bf16_t* L = (const bf16_t*)(P.ws + OFF_L);
  const bf16_t* Qm = L + L1_QM; const bf16_t* Kn = L + L1_KN; const bf16_t* Vt = L + L1_VT; const bf16_t* Kr = L + L1_KR; const bf16_t* Gc = L + L1_GC;
  bf16_t* cat = (bf16_t*)(P.ws + OFF_CAT);
  const size_t tb = (size_t)b * S;
  const size_t tq = tb + qt * 128 + w * 32 + l32;
  bf16x8 qf[6];
#pragma unroll
  for (int kk = 0; kk < 6; kk++) qf[kk] = *(const bf16x8*)(Qm + tq * 768 + hh * 96 + kk * 16 + h * 8);
  f32x16 o[2];
#pragma unroll
  for (int i = 0; i < 2; i++)
#pragma unroll
    for (int r = 0; r < 16; r++) o[i][r] = 0.f;
  float lsum = 0.f;
  f32x16 negm;
#pragma unroll
  for (int r = 0; r < 16; r++) negm[r] = 0.f;
  uint4 rk0, rk1, rk2, rv0, rv1, qk0, qk1, qk2, qv0, qv1;
  const bf16_t* vbase = Vt + (size_t)(b * 8 + hh) * 64 * S;
  const int kc0 = tid, kc1 = tid + 256, kc2 = tid + 512;
  const int kr0 = kc0 / 12, kq0 = kc0 % 12, kr1 = kc1 / 12, kq1 = kc1 % 12, kr2 = kc2 / 12, kq2 = kc2 % 12;
  const int vr0 = tid >> 3, vq0 = tid & 7, vr1 = (tid + 256) >> 3;
#define MLA_KSRC(row, q, k0) ((q) < 8 ? (Kn + (tb + (k0) + (row)) * 512 + hh * 64 + (q) * 8) : (Kr + (tb + (k0) + (row)) * 32 + ((q) - 8) * 8))
#define MLA_GLOAD(kt_, K0, K1, K2, V0, V1) { const int k0_ = (kt_) * 64; \
    K0 = *(const uint4*)MLA_KSRC(kr0, kq0, k0_); K1 = *(const uint4*)MLA_KSRC(kr1, kq1, k0_); K2 = *(const uint4*)MLA_KSRC(kr2, kq2, k0_); \
    V0 = *(const uint4*)(vbase + (size_t)vr0 * S + k0_ + vq0 * 8); V1 = *(const uint4*)(vbase + (size_t)vr1 * S + k0_ + vq0 * 8); }
#define MLA_LSTORE(buf_, K0, K1, K2, V0, V1) { bf16_t* sK_ = smem + (buf_) * ATT_STAGE_E; bf16_t* sV_ = sK_ + 64 * KLD; \
    *(uint4*)(sK_ + kr0 * KLD + kq0 * 8) = K0; *(uint4*)(sK_ + kr1 * KLD + kq1 * 8) = K1; *(uint4*)(sK_ + kr2 * KLD + kq2 * 8) = K2; \
    *(uint4*)(sV_ + vr0 * VLD + vq0 * 8) = V0; *(uint4*)(sV_ + vr1 * VLD + vq0 * 8) = V1; }
  const int nkt = S >> 6; const int lastk = nkt - 1;
  __syncthreads();
  MLA_GLOAD(0, rk0, rk1, rk2, rv0, rv1) MLA_GLOAD(1, qk0, qk1, qk2, qv0, qv1) MLA_LSTORE(0, rk0, rk1, rk2, rv0, rv1)
  __syncthreads();
  for (int kt = 0; kt < nkt; kt += 2) {
    { const int k2 = (kt + 2 < nkt) ? kt + 2 : lastk; MLA_GLOAD(k2, rk0, rk1, rk2, rv0, rv1) }
    mla_compute(smem, qf, o, negm, lsum, kt == 0, l32, h);
    MLA_LSTORE(1, qk0, qk1, qk2, qv0, qv1)
    __syncthreads();
    { const int k3 = (kt + 3 < nkt) ? kt + 3 : lastk; MLA_GLOAD(k3, qk0, qk1, qk2, qv0, qv1) }
    mla_compute(smem + ATT_STAGE_E, qf, o, negm, lsum, false, l32, h);
    MLA_LSTORE(0, rk0, rk1, rk2, rv0, rv1)
    __syncthreads();
  }
  lsum += __shfl_xor(lsum, 32);
  const float inv = 1.f / lsum;
#pragma unroll
  for (int dt = 0; dt < 2; dt++)
#pragma unroll
    for (int rq = 0; rq < 4; rq++) {
      const int dv = hh * 64 + dt * 32 + 8 * rq + 4 * h;
      const uint2 gu = *(const uint2*)(Gc + tq * 512 + dv);
      store4(cat + tix(tq, dv, 16), o[dt][4 * rq] * inv * siluf_(bflo(gu.x)), o[dt][4 * rq + 1] * inv * siluf_(bfhi(gu.x)),
             o[dt][4 * rq + 2] * inv * siluf_(bflo(gu.y)), o[dt][4 * rq + 3] * inv * siluf_(bfhi(gu.y)));
    }
}

DI void dft_mma(const bf16_t* sA, f32x16 (&accP)[2][2], f32x16 (&accQ)[2][2], int moff, int noff) {
  const bf16_t* sB = sA + TILE_E;
#pragma unroll
  for (int kk = 0; kk < 4; kk++) {
    bf16x8 fm0 = *(const bf16x8*)(sB + moff + kk * 16);
    bf16x8 fm1 = *(const bf16x8*)(sB + moff + 32 * LDT + kk * 16);
    bf16x8 fn0 = *(const bf16x8*)(sA + noff + kk * 16);
    bf16x8 fn1 = *(const bf16x8*)(sA + noff + 32 * LDT + kk * 16);
    if (kk < 2) {
      accP[0][0] = MFMA32(fm0, fn0, accP[0][0]); accP[0][1] = MFMA32(fm0, fn1, accP[0][1]);
      accP[1][0] = MFMA32(fm1, fn0, accP[1][0]); accP[1][1] = MFMA32(fm1, fn1, accP[1][1]);
    } else {
      accQ[0][0] = MFMA32(fm0, fn0, accQ[0][0]); accQ[0][1] = MFMA32(fm0, fn1, accQ[0][1]);
      accQ[1][0] = MFMA32(fm1, fn0, accQ[1][0]); accQ[1][1] = MFMA32(fm1, fn1, accQ[1][1]);
    }
  }
}
DI void dft_item(const Params& P, int g, int b, int ml, int ntc, bf16_t* smem) {
  WAVE_IDS
  const int S = g ? 4096 : 8192;
  const int ks0 = ml * 128, n0 = ntc * 128;
  const bf16_t* L = (const bf16_t*)(P.ws + OFF_L);
  const bf16_t* Yt = L + L1_YT; const bf16_t* Gd = L + L1_GD;
  bf16_t* cat = (bf16_t*)(P.ws + OFF_CAT);
  __syncthreads();
  f32x16 accP[2][2], accQ[2][2]; ZERO_ACC(accP) ZERO_ACC(accQ)
  LoadDft la; la.ks0 = ks0; la.S = S; la.invS = 1.f / (float)S; la.init(tid);
  const bf16_t* Yf = (const bf16_t*)(P.ws + OFF_YTF);
  LoadYt lb{Yf + (size_t)b * (S >> 1) * 1024 + (size_t)n0 * 32, S};
  {
    const int nk = S >> 6, last = nk - 1;
    uint4 a00, a01, a02, a03, b00, b01, b02, b03, b10, b11, b12, b13;
    la.load(0, tid, a00, a01, a02, a03); lb.load(0, tid, b00, b01, b02, b03);
    lb.load(1, tid, b10, b11, b12, b13);
    GEMM_ST1(smem, 0, a00, b00) GEMM_ST1(smem, 1, a01, b01) GEMM_ST1(smem, 2, a02, b02) GEMM_ST1(smem, 3, a03, b03)
    __syncthreads();
    const int moff = (wm * 64 + l32) * LDT + h * 8;
    const int noff = (wn * 64 + l32) * LDT + h * 8;
    bf16_t* buf0 = smem; bf16_t* buf1 = smem + 2 * TILE_E;
    for (int kt = 0; kt < nk; kt += 2) {
      { const int k2 = (kt + 2 < nk) ? kt + 2 : last; lb.load(k2, tid, b00, b01, b02, b03); }
      dft_mma(buf0, accP, accQ, moff, noff);
      la.load(kt + 1, tid, a00, a01, a02, a03);
      GEMM_ST1(buf1, 0, a00, b10) GEMM_ST1(buf1, 1, a01, b11) GEMM_ST1(buf1, 2, a02, b12) GEMM_ST1(buf1, 3, a03, b13)
      __syncthreads();
      { const int k3 = (kt + 3 < nk) ? kt + 3 : last; lb.load(k3, tid, b10, b11, b12, b13); }
      dft_mma(buf1, accP, accQ, moff, noff);
      { const int k2 = (kt + 2 < nk) ? kt + 2 : last; la.load(k2, tid, a00, a01, a02, a03); }
      GEMM_ST1(buf0, 0, a00, b00) GEMM_ST1(buf0, 1, a01, b01) GEMM_ST1(buf0, 2, a02, b02) GEMM_ST1(buf0, 3, a03, b03)
      __syncthreads();
    }
  }
  const float scale = rsqrtf((float)S * 128.f);
  const size_t tb = (size_t)b * S;
#pragma unroll
  for (int j = 0; j < 2; j++) {
    const int ks = ks0 + wn * 64 + j * 32 + l32;
    const size_t t1 = tb + ks; const size_t t2 = tb + ((S - ks) & (S - 1));
#pragma unroll
    for (int i = 0; i < 2; i++)
#pragma unroll
      for (int rq = 0; rq < 4; rq++) {
        const int ch = n0 + wm * 64 + i * 32 + 8 * rq + 4 * h;
        const uint2 g1 = *(const uint2*)(Gd + t1 * 512 + ch);
        const bf16_t* yh = Yt + (size_t)b * S * 1024 + ((size_t)(S >> 6) * 1024 + ch) * 32;
        const float sgn = (ks & 1) ? -1.f : 1.f;
        const float p0 = accP[i][j][4 * rq] + sgn * bf2f_(yh[0]), p1 = accP[i][j][4 * rq + 1] + sgn * bf2f_(yh[32]),
                    p2 = accP[i][j][4 * rq + 2] + sgn * bf2f_(yh[64]), p3 = accP[i][j][4 * rq + 3] + sgn * bf2f_(yh[96]);
        const float q0 = accQ[i][j][4 * rq], q1 = accQ[i][j][4 * rq + 1], q2 = accQ[i][j][4 * rq + 2], q3 = accQ[i][j][4 * rq + 3];
        store4(cat + tix(t1, 512 + ch, 16), (p0 + q0) * scale * siluf_(bflo(g1.x)), (p1 + q1) * scale * siluf_(bfhi(g1.x)),
               (p2 + q2) * scale * siluf_(bflo(g1.y)), (p3 + q3) * scale * siluf_(bfhi(g1.y)));
        if (ks != 0) {
          const uint2 g2 = *(const uint2*)(Gd + t2 * 512 + ch);
          store4(cat + tix(t2, 512 + ch, 16), (p0 - q0) * scale * siluf_(bflo(g2.x)), (p1 - q1) * scale * siluf_(bfhi(g2.x)),
                 (p2 - q2) * scale * siluf_(bflo(g2.y)), (p3 - q3) * scale * siluf_(bfhi(g2.y)));
        }
      }
  }
  if (ml == 0) {
    const int ch = tid & 127, part = tid >> 7;
    const bf16_t* yp = Yt + (size_t)b * S * 1024 + (size_t)(n0 + ch) * 32;
    float acc = 0.f;
    for (int sb = part; sb < (S >> 5); sb += 2) {
      const uint4* q = (const uint4*)(yp + (size_t)sb * 1024 * 32);
#pragma unroll
      for (int k = 0; k < 4; k++) { const uint4 u = q[k];
        acc += (bflo(u.x) - bfhi(u.x)) + (bflo(u.y) - bfhi(u.y)) + (bflo(u.z) - bfhi(u.z)) + (bflo(u.w) - bfhi(u.w)); }
    }
    float* red = (float*)smem;
    __syncthreads();
    red[tid] = acc;
    __syncthreads();
    if (part == 0) {
      const float v = (red[tid] + red[tid + 128]) * scale;
      const size_t th = tb + (S >> 1);
      const bf16_t gb = Gd[th * 512 + n0 + ch];
      const float gg = __uint_as_float((unsigned)gb << 16);
      cat[tix(th, 512 + n0 + ch, 16)] = (bf16_t)(pk2(v * siluf_(gg), 0.f) & 0xffffu);
    }
  }
}

DI int queue_take(unsigned* word, bool front, int tot, int* s_item) {
  if (otid() == 0) {
    const unsigned old = atomicAdd(word, front ? 1u : 0x10000u);
    const int f = old & 0xffff, bk = old >> 16;
    *s_item = (f + bk < tot) ? (front ? f : tot - 1 - bk) : -1;
  }
  __syncthreads();
  const int it = *s_item;
  __syncthreads();
  return it;
}
DI void ph_mix_o(const Params& P, int g, bf16_t* smem, int part, int* s_item, int rep) {
  const int S = g ? 4096 : 8192; const int B = g ? 16 : 8;
  const int bid = obid();
  const int x = bid & 7, slot = bid >> 3, nslot = gridDim.x >> 3, half = nslot >> 1;
  const int nqt = S >> 7;
  const int nmt = S >> 8;
  const int nxp = (g == 0) ? 32 : 0;
  const int nm = B * nqt, nd = (B >> 1) * nmt, tot = nm + nxp + nd;
  const bool fwd = slot < half;
  unsigned* word = (unsigned*)(P.ws + OFF_CNT) + (g * 2 + rep) * 8 + x;
  for (;;) {
    const int j = queue_take(word, fwd, tot, s_item);
    if (j < 0) break;
    if (j < nm) {
      if (part & 1) { const int bh = (j / nqt) * 8 + x, qt = j % nqt; mla_item(P, g, bh * nqt + qt, smem); }
    } else if (j < nm + nxp) {
      if (rep == 0) { const int tid0 = otid(); xprep_rows(P, 1, (x * 32 + (j - nm)) * 256, 256, tid0 >> 6, NTHR >> 6, tid0 & 63); }
    } else {
      if (part & 2) { const int jd = j - nm - nxp; const int pair = (jd / nmt) * 8 + x, ml = jd % nmt; dft_item(P, g, pair >> 2, ml, pair & 3, smem); }
    }
  }
}

#define XB_TMO      128
#define XB_XCNT(j)  (256  + 64 * (j))
#define XB_XSUB(j)  (1280 + 64 * (j))
#define XB_XGEN(j)  (2304 + 64 * (j))
#define XB_TOP      3328
#define XB_TOPGEN   3392
#define XCD_BAR_WORDS 3456
#define XB_SPIN_CAP (1u << 18)
#define LAS __attribute__((address_space(3)))

__device__ __forceinline__ unsigned xb_ld(unsigned* p)              { return __hip_atomic_load(p, __ATOMIC_RELAXED, __HIP_MEMORY_SCOPE_AGENT); }
__device__ __forceinline__ unsigned xb_add(unsigned* p, unsigned v) { return __hip_atomic_fetch_add(p, v, __ATOMIC_RELAXED, __HIP_MEMORY_SCOPE_AGENT); }
__device__ __forceinline__ unsigned xb_xcc_id() { return (unsigned)__builtin_amdgcn_s_getreg((3 << 11) | 20) & 0xFu; }
#define XB_SPIN(cond, bar) do { unsigned _sp = 0; while (cond) { __builtin_amdgcn_s_sleep(1); \
    if ((++_sp & 255u) == 0u) { if (xb_ld(&(bar)[XB_TMO])) break; if (_sp > XB_SPIN_CAP) { atomicAdd(&(bar)[XB_TMO], 1u); break; } } } } while (0)

struct XcdBarrier {
    unsigned* bar; unsigned x;
    volatile LAS unsigned* st;
};

__device__ __forceinline__ XcdBarrier xcd_barrier_post(unsigned* bar, volatile LAS unsigned* st) {
    XcdBarrier b; b.bar = bar; b.x = xb_xcc_id(); b.st = st;
    if (threadIdx.x == 0) (void)xb_add(&bar[XB_XCNT(b.x)], 1u);
    return b;
}
__device__ __forceinline__ void xcd_barrier_complete(unsigned* bar, unsigned x, unsigned& nloc, unsigned& nx) {
    const unsigned G = gridDim.x * gridDim.y * gridDim.z;
    unsigned sum, cnt, mine, sp = 0u;
    for (;;) {
        sum = 0u; cnt = 0u; mine = 0u;
#pragma unroll
        for (unsigned j = 0; j < 16; ++j) { const unsigned c = xb_ld(&bar[XB_XCNT(j)]); sum += c; cnt += (c > 0u) ? 1u : 0u; mine = (j == x) ? c : mine; }
        if (sum == G) break;
        __builtin_amdgcn_s_sleep(1);
        if ((++sp & 255u) == 0u) { if (xb_ld(&bar[XB_TMO])) break; if (sp > XB_SPIN_CAP) { atomicAdd(&bar[XB_TMO], 1u); break; } }
    }
    nloc = mine > 0u ? mine : 1u; nx = cnt > 0u ? cnt : 1u;
}

__device__ __forceinline__ void xcd_barrier(const XcdBarrier& b) {
    asm volatile("s_waitcnt vmcnt(0)" ::: "memory");
    __syncthreads();
    if (threadIdx.x == 0) {
        unsigned* bar = b.bar;
        __builtin_amdgcn_s_waitcnt(0);
        unsigned nloc = b.st[0], nx = b.st[1];
        if (nloc == 0u) { xcd_barrier_complete(bar, b.x, nloc, nx); b.st[0] = nloc; b.st[1] = nx; }
        const unsigned old = xb_add(&bar[XB_XSUB(b.x)], 1u);
        const unsigned gen = old / nloc;
        if (old + 1u == (gen + 1u) * nloc) {
            __builtin_amdgcn_fence(__ATOMIC_RELEASE, "agent");
            asm volatile("s_waitcnt vmcnt(0)" ::: "memory");
            const unsigned og = xb_add(&bar[XB_TOP], 1u);
            const unsigned tg = og / nx;
            if (og + 1u == (tg + 1u) * nx) xb_add(&bar[XB_TOPGEN], 1u);
            else XB_SPIN(xb_ld(&bar[XB_TOPGEN]) == tg, bar);
            __builtin_amdgcn_fence(__ATOMIC_ACQUIRE, "agent");
            xb_add(&bar[XB_XGEN(b.x)], 1u);
            asm volatile("s_waitcnt vmcnt(0)" ::: "memory");
        } else {
            XB_SPIN(xb_ld(&bar[XB_XGEN(b.x)]) == gen, bar);
            __builtin_amdgcn_fence(__ATOMIC_ACQUIRE, "agent");
            asm volatile("s_waitcnt vmcnt(0)" ::: "memory");
        }
    }
    __syncthreads();
}


constexpr int NPH = 23;
#ifndef ONLY_SUB
#define ONLY_SUB -1
#endif
#ifndef REP_MASK
#define REP_MASK 0
#endif
#ifndef MIXO_REP_PART
#define MIXO_REP_PART 3
#endif
DI void run_phase(const Params& P, int ph, bf16_t* smem, float* s_rs, int rep, int* s_item) {
  if (ph == 0) { if (ONLY_SUB < 0 || ONLY_SUB == 99) { ph_prelude(P); ph_xprep(P, 0); } return; }
  const int g = (ph - 1) / 11; int sub = (ph - 1) % 11;
  if (ONLY_SUB >= 0) { if (sub != ONLY_SUB) return; sub = ONLY_SUB; }
  switch (sub) {
    case 0: ph_in_e(P, g, smem, s_rs); break;
    case 1: ph_mix_e(P, g, smem, s_item, rep); break;
    case 2: ph_out(P, 0, smem); break;
    case 3: ph_resid(P, g, 0); break;
    case 4: ph_ple(P, g, 0, smem); break;
    case 5: ph_in_o(P, g, smem, s_rs); break;
    case 6: ph_up(P, g, smem, s_rs); yt_fold(P, g); break;
    case 7: ph_mix_o(P, g, smem, rep == 0 ? 3 : MIXO_REP_PART, s_item, rep); break;
    case 8: ph_out(P, 1, smem); break;
    case 9: ph_resid(P, g, 1); break;
    default: ph_ple(P, g, 1, smem); break;
  }
}

__global__ void __launch_bounds__(NTHR, 2) mega(Params P, int ph_lo, int ph_hi, int rep0) {
  __shared__ __attribute__((aligned(16))) bf16_t smem[SMEM_E];
  __shared__ float s_rs[256];
  __shared__ int s_item;
  __shared__ uint4 xb_words;
  if (threadIdx.x == 0) xb_words = make_uint4(0u, 0u, 0u, 0u);
  __syncthreads();
  (void)xcd_barrier_post((unsigned*)(P.ws + OFF_BAR), (volatile LAS unsigned*)&xb_words);
  bool first_sync = true;
  for (int ph = ph_lo; ph < ph_hi; ph++) {
    const int sub = (ph == 0) ? 31 : (ph - 1) % 11;
    const int reps = 1 + ((REP_MASK >> sub) & 1);
    for (int rep = 0; rep < reps; rep++) {
      run_phase(P, ph, smem, s_rs, rep + rep0, &s_item);
      if (ph + 1 < ph_hi || rep + 1 < reps) {
        if (first_sync) { cg::this_grid().sync(); first_sync = false; } else { XcdBarrier xb; xb.bar = (unsigned*)(P.ws + OFF_BAR); xb.x = xb_xcc_id(); xb.st = (volatile LAS unsigned*)&xb_words; xcd_barrier(xb); }
      }
    }
  }
}

extern "C" void kernel_launch(void* const* d_in, const int* in_sizes, int n_in, void* d_out, int out_size, void* d_ws, size_t ws_size,
                              hipStream_t stream) {
  static int grid_blocks = 0;
  if (!grid_blocks) {
    int dev = 0, cus = 0, per_cu = 0;
    hipGetDevice(&dev);
    hipDeviceGetAttribute(&cus, hipDeviceAttributeMultiprocessorCount, dev);
    hipOccupancyMaxActiveBlocksPerMultiprocessor(&per_cu, mega, NTHR, 0);
    if (per_cu < 1) per_cu = 1;
    if (per_cu > 2) per_cu = 2;
    grid_blocks = cus * per_cu;
  }
  Params P{};
  P.x0 = (const float*)d_in[0]; P.x1 = (const float*)d_in[1]; P.p0 = (const float*)d_in[2]; P.p1 = (const float*)d_in[3];
  P.y0 = (float*)d_out; P.y1 = (float*)d_out + (size_t)TOK * 1024;
  P.g_pre = (const float*)d_in[4]; P.g_post = (const float*)d_in[5]; P.w_ple = (const float*)d_in[6]; P.w_ple_gate = (const float*)d_in[7];
  P.w_in_e = (const float*)d_in[8]; P.rpb = (const float*)d_in[9]; P.dw_w = (const float*)d_in[10]; P.dw_b = (const float*)d_in[11];
  P.cln_g = (const float*)d_in[12]; P.cln_b = (const float*)d_in[13]; P.w_out_e = (const float*)d_in[14]; P.w_in_o = (const float*)d_in[15];
  P.q_norm_g = (const float*)d_in[16]; P.kv_norm_g = (const float*)d_in[17]; P.w_uq = (const float*)d_in[18]; P.w_ukv = (const float*)d_in[19];
  P.w_out_o = (const float*)d_in[20];
  P.ws = (char*)d_ws;
  for (int i = 0; i < 16; i++) P.inv_freq[i] = powf(10000.0f, -(float)(2 * i) / 32.0f);
#if MK_COOP
  hipMemsetAsync((char*)d_ws + OFF_BAR, 0, XCD_BAR_WORDS * sizeof(unsigned), stream);
  int lo = 0, hi = NPH, rep0 = 0;
  void* args[] = {&P, &lo, &hi, &rep0};
  hipError_t e = hipLaunchCooperativeKernel((void*)mega, dim3(grid_blocks), dim3(NTHR), args, 0, stream);
  if (e != hipSuccess) fprintf(stderr, "cooperative launch failed: %s (grid %d)\n", hipGetErrorString(e), grid_blocks);
#else
#ifndef HOST_REP_MASK
#define HOST_REP_MASK 0u
#endif
  for (int ph = 0; ph < NPH; ph++) {
    mega<<<dim3(grid_blocks), dim3(NTHR), 0, stream>>>(P, ph, ph + 1, 0);
    const int sub = (ph == 0) ? 31 : (ph - 1) % 11;
    if ((HOST_REP_MASK >> sub) & 1u) mega<<<dim3(grid_blocks), dim3(NTHR), 0, stream>>>(P, ph, ph + 1, 1);
  }
#endif
}
```

```cpp
#include <hip/hip_runtime.h>
#include <hip/hip_cooperative_groups.h>
#include <cstdio>
#include <cmath>
namespace cg = cooperative_groups;

#ifndef MK_COOP
#define MK_COOP 1
#endif
#ifndef MIXE_REP_PART
#define MIXE_REP_PART 3
#endif

typedef unsigned short bf16_t;
typedef short bf16x8 __attribute__((ext_vector_type(8)));
typedef float f32x16 __attribute__((ext_vector_type(16)));
typedef float f32x4 __attribute__((ext_vector_type(4)));
typedef __bf16 bf16v2 __attribute__((ext_vector_type(2)));
typedef float f32v2 __attribute__((ext_vector_type(2)));
#define DI __device__ __forceinline__
#define MFMA32(a, b, c) __builtin_amdgcn_mfma_f32_32x32x16_bf16((a), (b), (c), 0, 0, 0)
#define MFMA16(a, b, c) __builtin_amdgcn_mfma_f32_16x16x32_bf16((a), (b), (c), 0, 0, 0)

constexpr int TOK = 65536;
constexpr float EPS = 1e-6f;
constexpr float LOG2E = 1.4426950408889634f;
constexpr int NTHR = 256;

constexpr size_t MBy = 1u << 20;
constexpr size_t OFF_WINE = 0;
constexpr size_t OFF_WOUTE = 7 * MBy;
constexpr size_t OFF_WOUTO = 9 * MBy;
constexpr size_t OFF_WG0 = 11 * MBy;
constexpr size_t OFF_WG1 = 13 * MBy;
constexpr size_t OFF_WE0 = 15 * MBy;
constexpr size_t OFF_WE1 = 15 * MBy + 512 * 1024;
constexpr size_t OFF_WINO = 16 * MBy;
constexpr size_t OFF_WUQ = 21 * MBy;
constexpr size_t OFF_WUKV = 21 * MBy + 512 * 1024;
constexpr size_t OFF_ROPEC = 22 * MBy;
constexpr size_t OFF_ROPES = 22 * MBy + 512 * 1024;
constexpr size_t OFF_RSIN = 23 * MBy;
constexpr size_t OFF_SS = 24 * MBy;
constexpr size_t OFF_SSX = 28 * MBy;
constexpr size_t OFF_SSQ = 32 * MBy;
constexpr size_t OFF_SSKV = 33 * MBy;
constexpr size_t OFF_CNT = 33 * MBy + 768 * 1024;
constexpr size_t OFF_BAR = 33 * MBy + 800 * 1024;
constexpr size_t OFF_CAT = 34 * MBy;
constexpr size_t OFF_X2B = 162 * MBy;
constexpr size_t OFF_L = 290 * MBy;
constexpr size_t OFF_XB1 = 824 * MBy;
constexpr size_t OFF_YTF = 952 * MBy;
constexpr size_t ME = 1u << 20;
constexpr size_t L0_Q = 0, L0_K = 32 * ME, L0_VT = 64 * ME, L0_GA = 96 * ME, L0_UA = 128 * ME, L0_UB = 160 * ME, L0_GB = 192 * ME;
constexpr size_t L0_OB = 0, L0_X1B = 128 * ME;
constexpr size_t L1_YT = 0, L1_QM = 64 * ME, L1_KN = 112 * ME, L1_VT = 144 * ME, L1_GC = 176 * ME, L1_GD = 208 * ME,
                 L1_CQ = 240 * ME, L1_CKV = 256 * ME, L1_KR = 264 * ME;
constexpr size_t L1_OB = 0, L1_X1B = 64 * ME;

struct Params {
  const float* x0; const float* x1; const float* p0; const float* p1;
  float* y0; float* y1;
  const float* g_pre; const float* g_post; const float* w_ple; const float* w_ple_gate;
  const float* w_in_e; const float* rpb; const float* dw_w; const float* dw_b; const float* cln_g; const float* cln_b;
  const float* w_out_e; const float* w_in_o; const float* q_norm_g; const float* kv_norm_g;
  const float* w_uq; const float* w_ukv; const float* w_out_o;
  char* ws;
  float inv_freq[16];
};

DI unsigned pk2(float a, float b) { f32v2 v = {a, b}; return __builtin_bit_cast(unsigned, __builtin_convertvector(v, bf16v2)); }
DI float bflo(unsigned u) { return __uint_as_float(u << 16); }
DI float bfhi(unsigned u) { return __uint_as_float(u & 0xffff0000u); }
DI float4 ldg_nt(const float* p) { const f32x4 v = __builtin_nontemporal_load((const f32x4*)p); return make_float4(v[0], v[1], v[2], v[3]); }
DI void stg_nt(float* p, float4 a) { f32x4 v = {a.x, a.y, a.z, a.w}; __builtin_nontemporal_store(v, (f32x4*)p); }
DI float bf2f_(bf16_t v) { return __uint_as_float((unsigned)v << 16); }
DI float sigmoidf_(float v) { return 1.f / (1.f + __expf(-v)); }
DI float siluf_(float v) { return v / (1.f + __expf(-v)); }
DI void store4(bf16_t* p, float a, float b, float c, float d) { *(uint2*)p = make_uint2(pk2(a, b), pk2(c, d)); }
DI int otid() { int t = threadIdx.x; asm volatile("" : "+v"(t)); return t; }
DI int obid() { int t = blockIdx.x; asm volatile("" : "+s"(t)); return t; }
DI float wave_sum(float s) {
#pragma unroll
  for (int o = 32; o; o >>= 1) s += __shfl_xor(s, o);
  return s;
}

constexpr int LDT = 72;
constexpr int TILE_E = 128 * LDT;
constexpr int SMEM_E = 4 * TILE_E;

struct LoadBf16 {
  static constexpr bool LATE = false;
  const bf16_t* base; int ld;
  DI void pos(int i, int tid, int& row, int& kc) const { int c = tid + 256 * i; row = c >> 3; kc = c & 7; }
  DI uint4 ld1(int kt, int i, int tid) const { int row, kc; pos(i, tid, row, kc); return *(const uint4*)(base + (size_t)row * ld + kt * 64 + kc * 8); }
  DI void load(int kt, int tid, uint4& r0, uint4& r1, uint4& r2, uint4& r3) const { r0 = ld1(kt, 0, tid); r1 = ld1(kt, 1, tid); r2 = ld1(kt, 2, tid); r3 = ld1(kt, 3, tid); }
};
DI size_t tix(size_t t, int f, int KT) { return ((t >> 7) * KT + (f >> 6)) * 8192 + (t & 127) * 64 + (f & 63); }
struct LoadTile {
  static constexpr bool LATE = false;
  const bf16_t* base;
  DI void pos(int i, int tid, int& row, int& kc) const { int c = tid + 256 * i; row = c >> 3; kc = c & 7; }
  DI uint4 ld1(int kt, int i, int tid) const { return *(const uint4*)(base + (size_t)kt * 8192 + (tid + 256 * i) * 8); }
  DI void load(int kt, int tid, uint4& r0, uint4& r1, uint4& r2, uint4& r3) const { r0 = ld1(kt, 0, tid); r1 = ld1(kt, 1, tid); r2 = ld1(kt, 2, tid); r3 = ld1(kt, 3, tid); }
};
struct LoadF32 {
  static constexpr bool LATE = false;
  const float* base; int ld;
  DI void pos(int i, int tid, int& row, int& kc) const { int c = tid + 256 * i; row = c >> 3; kc = c & 7; }
  DI uint4 ld1(int kt, int i, int tid) const {
    int row, kc; pos(i, tid, row, kc);
    const float* s = base + (size_t)row * ld + kt * 64 + kc * 8;
    float4 a = *(const float4*)s, b = *(const float4*)(s + 4);
    return make_uint4(pk2(a.x, a.y), pk2(a.z, a.w), pk2(b.x, b.y), pk2(b.z, b.w));
  }
  DI void load(int kt, int tid, uint4& r0, uint4& r1, uint4& r2, uint4& r3) const { r0 = ld1(kt, 0, tid); r1 = ld1(kt, 1, tid); r2 = ld1(kt, 2, tid); r3 = ld1(kt, 3, tid); }
};
struct LoadYt {
  static constexpr bool LATE = false;
  const bf16_t* base; int S;
  DI void pos(int i, int tid, int& row, int& kc) const { int c = tid + 256 * i; row = c >> 3; kc = c & 7; }
  DI uint4 ld1(int kt, int i, int tid) const { int row, kc; pos(i, tid, row, kc); return *(const uint4*)(base + ((size_t)kt * 1024 + (kc >> 2) * 512 + row) * 32 + (kc & 3) * 8); }
  DI void load(int kt, int tid, uint4& r0, uint4& r1, uint4& r2, uint4& r3) const { r0 = ld1(kt, 0, tid); r1 = ld1(kt, 1, tid); r2 = ld1(kt, 2, tid); r3 = ld1(kt, 3, tid); }
};
struct LoadDft {
  static constexpr bool LATE = true;
  int ks0, S; float invS; float cd0, sd0, cd1, sd1;
  DI void init(int tid) {
    { int row = tid >> 2; float f = (float)(ks0 + row) * invS; cd0 = __builtin_amdgcn_cosf(f); sd0 = __builtin_amdgcn_sinf(f); }
    { int row = (tid + 256) >> 2; float f = (float)(ks0 + row) * invS; cd1 = __builtin_amdgcn_cosf(f); sd1 = __builtin_amdgcn_sinf(f); }
  }
  DI void pos(int i, int tid, int& row, int& kc) const { int q = tid + 256 * (i >> 1); row = q >> 2; kc = (q & 3) + 4 * (i & 1); }
  DI void gen(int kt, int q, float cd, float sd, uint4& rc, uint4& rs) const {
    const int row = q >> 2, seg = q & 3;
    const int ks = ks0 + row; const int sst = kt * 32 + seg * 8;
    const int idx = (ks * sst) & (S - 1);
    const float f = (float)idx * invS;
    const float c0 = __builtin_amdgcn_cosf(f), s0 = __builtin_amdgcn_sinf(f);
    const float c1 = c0 * cd - s0 * sd, s1 = s0 * cd + c0 * sd;
    const float c2 = c1 * cd - s1 * sd, s2 = s1 * cd + c1 * sd;
    const float c3 = c2 * cd - s2 * sd, s3 = s2 * cd + c2 * sd;
    const float c4 = c3 * cd - s3 * sd, s4 = s3 * cd + c3 * sd;
    const float c5 = c4 * cd - s4 * sd, s5 = s4 * cd + c4 * sd;
    const float c6 = c5 * cd - s5 * sd, s6 = s5 * cd + c5 * sd;
    const float c7 = c6 * cd - s6 * sd, s7 = s6 * cd + c6 * sd;
    rc = make_uint4(pk2(c0, c1), pk2(c2, c3), pk2(c4, c5), pk2(c6, c7));
    rs = make_uint4(pk2(-s0, -s1), pk2(-s2, -s3), pk2(-s4, -s5), pk2(-s6, -s7));
  }
  DI void load(int kt, int tid, uint4& r0, uint4& r1, uint4& r2, uint4& r3) const { gen(kt, tid, cd0, sd0, r0, r1); gen(kt, tid + 256, cd1, sd1, r2, r3); }
};

#define GEMM_ST1(sA_, i_, va_, vb_) { int row, kc; la.pos(i_, tid, row, kc); *(uint4*)((sA_) + row * LDT + kc * 8) = va_; \
    lb.pos(i_, tid, row, kc); *(uint4*)((sA_) + TILE_E + row * LDT + kc * 8) = vb_; }
DI void gemm_mma(const bf16_t* sA, f32x16 (&acc)[2][2], const bool swap, int moff, int noff) {
  const bf16_t* sB = sA + TILE_E;
  const bf16_t* sM = swap ? sB : sA; const bf16_t* sN = swap ? sA : sB;
#pragma unroll
  for (int kk = 0; kk < 4; kk++) {
    bf16x8 fm0 = *(const bf16x8*)(sM + moff + kk * 16);
    bf16x8 fm1 = *(const bf16x8*)(sM + moff + 32 * LDT + kk * 16);
    bf16x8 fn0 = *(const bf16x8*)(sN + noff + kk * 16);
    bf16x8 fn1 = *(const bf16x8*)(sN + noff + 32 * LDT + kk * 16);
    acc[0][0] = MFMA32(fm0, fn0, acc[0][0]); acc[0][1] = MFMA32(fm0, fn1, acc[0][1]);
    acc[1][0] = MFMA32(fm1, fn0, acc[1][0]); acc[1][1] = MFMA32(fm1, fn1, acc[1][1]);
  }
}
template <class LA, class LB>
DI void gemm_core(const LA& la, const LB& lb, const int nk, bf16_t* smem, f32x16 (&acc)[2][2], const bool swap) {
  const int tid = otid();
  const int lane = tid & 63, w = tid >> 6, wm = w >> 1, wn = w & 1, l32 = lane & 31, h = lane >> 5;
  uint4 a00, a01, a02, a03, b00, b01, b02, b03, a10, a11, a12, a13, b10, b11, b12, b13;
  const int last = nk - 1;
  la.load(0, tid, a00, a01, a02, a03); lb.load(0, tid, b00, b01, b02, b03);
  { const int k1 = last < 1 ? last : 1; if (!LA::LATE) la.load(k1, tid, a10, a11, a12, a13); lb.load(k1, tid, b10, b11, b12, b13); }
  bf16_t* buf0 = smem; bf16_t* buf1 = smem + 2 * TILE_E;
  GEMM_ST1(buf0, 0, a00, b00) GEMM_ST1(buf0, 1, a01, b01) GEMM_ST1(buf0, 2, a02, b02) GEMM_ST1(buf0, 3, a03, b03)
  __syncthreads();
  const int moff = (wm * 64 + l32) * LDT + h * 8;
  const int noff = (wn * 64 + l32) * LDT + h * 8;
  for (int kt = 0; kt < nk; kt += 2) {
    { const int k2 = (kt + 2 < nk) ? kt + 2 : last; if (!LA::LATE) la.load(k2, tid, a00, a01, a02, a03); lb.load(k2, tid, b00, b01, b02, b03); }
    gemm_mma(buf0, acc, swap, moff, noff);
    if (LA::LATE) la.load(kt + 1, tid, a10, a11, a12, a13);
    GEMM_ST1(buf1, 0, a10, b10) GEMM_ST1(buf1, 1, a11, b11) GEMM_ST1(buf1, 2, a12, b12) GEMM_ST1(buf1, 3, a13, b13)
    __syncthreads();
    { const int k3 = (kt + 3 < nk) ? kt + 3 : last; if (!LA::LATE) la.load(k3, tid, a10, a11, a12, a13); lb.load(k3, tid, b10, b11, b12, b13); }
    gemm_mma(buf1, acc, swap, moff, noff);
    if (LA::LATE) { const int k2 = (kt + 2 < nk) ? kt + 2 : last; la.load(k2, tid, a00, a01, a02, a03); }
    GEMM_ST1(buf0, 0, a00, b00) GEMM_ST1(buf0, 1, a01, b01) GEMM_ST1(buf0, 2, a02, b02) GEMM_ST1(buf0, 3, a03, b03)
    __syncthreads();
  }
}

struct WFrag { bf16x8 f[2][4]; };
template <bool swap, class LA>
DI void gemm_core_ws(const LA& la, const bf16_t* Wt, const int KS, const int nk, bf16_t* smem, f32x16 (&acc)[2][2]) {
  const int tid = otid();
  const int lane = tid & 63, w = tid >> 6, wm = w >> 1, wn = w & 1, l32 = lane & 31, h = lane >> 5;
  const int fb = swap ? wm : wn, tbk = swap ? wn : wm;
  const bf16_t* wp0 = Wt + ((size_t)(fb * 2) * KS) * 512 + lane * 8;
  const bf16_t* wp1 = wp0 + (size_t)KS * 512;
  uint4 a00, a01, a02, a03, a10, a11, a12, a13;
  bf16x8 w00, w01, w02, w03, w04, w05, w06, w07, w10, w11, w12, w13, w14, w15, w16, w17;
  const int last = nk - 1;
#define WLOAD(kt_, p0, p1, p2, p3, p4, p5, p6, p7) { const bf16_t* q0_ = wp0 + (size_t)(kt_) * 2048; const bf16_t* q1_ = wp1 + (size_t)(kt_) * 2048; \
    p0 = *(const bf16x8*)q0_; p1 = *(const bf16x8*)(q0_ + 512); p2 = *(const bf16x8*)(q0_ + 1024); p3 = *(const bf16x8*)(q0_ + 1536); \
    p4 = *(const bf16x8*)q1_; p5 = *(const bf16x8*)(q1_ + 512); p6 = *(const bf16x8*)(q1_ + 1024); p7 = *(const bf16x8*)(q1_ + 1536); }
#define AST1(sA_, i_, va_) { int row, kc; la.pos(i_, tid, row, kc); *(uint4*)((sA_) + row * LDT + kc * 8) = va_; }
#define WMMA(sA_, p0, p1, p2, p3, p4, p5, p6, p7) { const bf16_t* sp_ = (sA_) + aoff; \
    if (swap) { \
      { bf16x8 t0 = *(const bf16x8*)(sp_), t1 = *(const bf16x8*)(sp_ + 32 * LDT); \
        acc[0][0] = MFMA32(p0, t0, acc[0][0]); acc[0][1] = MFMA32(p0, t1, acc[0][1]); acc[1][0] = MFMA32(p4, t0, acc[1][0]); acc[1][1] = MFMA32(p4, t1, acc[1][1]); } \
      { bf16x8 t0 = *(const bf16x8*)(sp_ + 16), t1 = *(const bf16x8*)(sp_ + 32 * LDT + 16); \
        acc[0][0] = MFMA32(p1, t0, acc[0][0]); acc[0][1] = MFMA32(p1, t1, acc[0][1]); acc[1][0] = MFMA32(p5, t0, acc[1][0]); acc[1][1] = MFMA32(p5, t1, acc[1][1]); } \
      { bf16x8 t0 = *(const bf16x8*)(sp_ + 32), t1 = *(const bf16x8*)(sp_ + 32 * LDT + 32); \
        acc[0][0] = MFMA32(p2, t0, acc[0][0]); acc[0][1] = MFMA32(p2, t1, acc[0][1]); acc[1][0] = MFMA32(p6, t0, acc[1][0]); acc[1][1] = MFMA32(p6, t1, acc[1][1]); } \
      { bf16x8 t0 = *(const bf16x8*)(sp_ + 48), t1 = *(const bf16x8*)(sp_ + 32 * LDT + 48); \
        acc[0][0] = MFMA32(p3, t0, acc[0][0]); acc[0][1] = MFMA32(p3, t1, acc[0][1]); acc[1][0] = MFMA32(p7, t0, acc[1][0]); acc[1][1] = MFMA32(p7, t1, acc[1][1]); } \
    } else { \
      { bf16x8 t0 = *(const bf16x8*)(sp_), t1 = *(const bf16x8*)(sp_ + 32 * LDT); \
        acc[0][0] = MFMA32(t0, p0, acc[0][0]); acc[0][1] = MFMA32(t0, p4, acc[0][1]); acc[1][0] = MFMA32(t1, p0, acc[1][0]); acc[1][1] = MFMA32(t1, p4, acc[1][1]); } \
      { bf16x8 t0 = *(const bf16x8*)(sp_ + 16), t1 = *(const bf16x8*)(sp_ + 32 * LDT + 16); \
        acc[0][0] = MFMA32(t0, p1, acc[0][0]); acc[0][1] = MFMA32(t0, p5, acc[0][1]); acc[1][0] = MFMA32(t1, p1, acc[1][0]); acc[1][1] = MFMA32(t1, p5, acc[1][1]); } \
      { bf16x8 t0 = *(const bf16x8*)(sp_ + 32), t1 = *(const bf16x8*)(sp_ + 32 * LDT + 32); \
        acc[0][0] = MFMA32(t0, p2, acc[0][0]); acc[0][1] = MFMA32(t0, p6, acc[0][1]); acc[1][0] = MFMA32(t1, p2, acc[1][0]); acc[1][1] = MFMA32(t1, p6, acc[1][1]); } \
      { bf16x8 t0 = *(const bf16x8*)(sp_ + 48), t1 = *(const bf16x8*)(sp_ + 32 * LDT + 48); \
        acc[0][0] = MFMA32(t0, p3, acc[0][0]); acc[0][1] = MFMA32(t0, p7, acc[0][1]); acc[1][0] = MFMA32(t1, p3, acc[1][0]); acc[1][1] = MFMA32(t1, p7, acc[1][1]); } \
    } }
  la.load(0, tid, a00, a01, a02, a03);
  WLOAD(0, w00, w01, w02, w03, w04, w05, w06, w07)
  { const int k1 = last < 1 ? last : 1; la.load(k1, tid, a10, a11, a12, a13); WLOAD(k1, w10, w11, w12, w13, w14, w15, w16, w17) }
  bf16_t* buf0 = smem; bf16_t* buf1 = smem + TILE_E;
  AST1(buf0, 0, a00) AST1(buf0, 1, a01) AST1(buf0, 2, a02) AST1(buf0, 3, a03)
  __syncthreads();
  const int aoff = (tbk * 64 + l32) * LDT + h * 8;
  for (int kt = 0; kt < nk; kt += 2) {
    const int k2 = (kt + 2 < nk) ? kt + 2 : last, k3 = (kt + 3 < nk) ? kt + 3 : last;
    la.load(k2, tid, a00, a01, a02, a03);
    WMMA(buf0, w00, w01, w02, w03, w04, w05, w06, w07)
    WLOAD(k2, w00, w01, w02, w03, w04, w05, w06, w07)
    AST1(buf1, 0, a10) AST1(buf1, 1, a11) AST1(buf1, 2, a12) AST1(buf1, 3, a13)
    __syncthreads();
    la.load(k3, tid, a10, a11, a12, a13);
    WMMA(buf1, w10, w11, w12, w13, w14, w15, w16, w17)
    WLOAD(k3, w10, w11, w12, w13, w14, w15, w16, w17)
    AST1(buf0, 0, a00) AST1(buf0, 1, a01) AST1(buf0, 2, a02) AST1(buf0, 3, a03)
    __syncthreads();
  }
}

template <class LA>
DI void gemm_core_w(const LA& la, const bf16_t* Wt, const int KS, const int nk, bf16_t* smem, f32x16 (&acc)[2][2], const bool swap) {
  if (swap) gemm_core_ws<true>(la, Wt, KS, nk, smem, acc); else gemm_core_ws<false>(la, Wt, KS, nk, smem, acc);
}

DI bool tile_sched(int bid, int it, int NT, int PW, int& mt, int& nt) {
  const int x = bid & 7, slot = bid >> 3, nslot = gridDim.x >> 3;
  const int j = slot + it * nslot;
  if (j >= 64 * NT) return false;
  const int ppan = 64 * PW; const int panel = j / ppan, rem = j - panel * ppan;
  const int ml = rem / PW; nt = panel * PW + (rem - ml * PW); mt = x * 64 + ml;
  return true;
}

#define ZERO_ACC(a) { _Pragma("unroll") for (int i_ = 0; i_ < 2; i_++) _Pragma("unroll") for (int j_ = 0; j_ < 2; j_++) _Pragma("unroll") for (int r_ = 0; r_ < 16; r_++) a[i_][j_][r_] = 0.f; }
#define WAVE_IDS const int tid = otid(); const int bid = obid(); (void)bid; const int lane = tid & 63, w = tid >> 6, wm = w >> 1, wn = w & 1, l32 = lane & 31, h = lane >> 5; (void)lane; (void)wm; (void)wn; (void)l32; (void)h;

constexpr int ATILE_E = 256 * LDT;
struct LoadTile256 {
  const bf16_t* base; int half_stride;
  DI uint4 ld1(int kt, int i, int tid) const { return *(const uint4*)(base + (size_t)(i >> 2) * half_stride + (size_t)kt * 8192 + (tid + 256 * (i & 3)) * 8); }
};
struct LoadF32x256 {
  const float* base; int ld;
  DI uint4 ld1(int kt, int i, int tid) const {
    const int c = tid + 256 * i; const int row = c >> 3, kc = c & 7;
    const float* s = base + (size_t)row * ld + kt * 64 + kc * 8;
    float4 a = *(const float4*)s, b = *(const float4*)(s + 4);
    return make_uint4(pk2(a.x, a.y), pk2(a.z, a.w), pk2(b.x, b.y), pk2(b.z, b.w));
  }
};
template <bool swap, class LA>
DI void gemm256_ws(const LA& la, const bf16_t* Wt, const int KS, const int nk, bf16_t* smem, f32x16 (&acc)[8]) {
  const int tid = otid();
  const int lane = tid & 63, w = tid >> 6, wm = w >> 1, wn = w & 1, l32 = lane & 31, h = lane >> 5;
  const int fb = swap ? wm : wn, tbk = swap ? wn : wm;
  const bf16_t* wp0 = Wt + ((size_t)(fb * 2) * KS) * 512 + lane * 8;
  const bf16_t* wp1 = wp0 + (size_t)KS * 512;
  uint4 a0, a1, a2, a3;
  bf16x8 w00, w01, w02, w03, w10, w11, w12, w13;
  const int last = nk - 1;
#define A256_LOADH(kt_, hf_) { a0 = la.ld1(kt_, (hf_) * 4 + 0, tid); a1 = la.ld1(kt_, (hf_) * 4 + 1, tid); a2 = la.ld1(kt_, (hf_) * 4 + 2, tid); a3 = la.ld1(kt_, (hf_) * 4 + 3, tid); }
#define A256_STH(sA_, hf_) { bf16_t* d_ = (sA_) + ((hf_) * 128 + (tid >> 3)) * LDT + (tid & 7) * 8; \
    *(uint4*)(d_) = a0; *(uint4*)(d_ + 32 * LDT) = a1; *(uint4*)(d_ + 64 * LDT) = a2; *(uint4*)(d_ + 96 * LDT) = a3; }
#define W256_LD(kt_, kk_, p0, p1) { p0 = *(const bf16x8*)(wp0 + (size_t)(kt_) * 2048 + (kk_) * 512); p1 = *(const bf16x8*)(wp1 + (size_t)(kt_) * 2048 + (kk_) * 512); }
#define MMA256(kk_, p0, p1) { const bf16_t* q_ = sp + (kk_) * 16; \
    const bf16x8 t0 = *(const bf16x8*)(q_), t1 = *(const bf16x8*)(q_ + 32 * LDT), t2 = *(const bf16x8*)(q_ + 64 * LDT), t3 = *(const bf16x8*)(q_ + 96 * LDT); \
    if (swap) { acc[0] = MFMA32(p0, t0, acc[0]); acc[1] = MFMA32(p0, t1, acc[1]); acc[2] = MFMA32(p0, t2, acc[2]); acc[3] = MFMA32(p0, t3, acc[3]); \
                acc[4] = MFMA32(p1, t0, acc[4]); acc[5] = MFMA32(p1, t1, acc[5]); acc[6] = MFMA32(p1, t2, acc[6]); acc[7] = MFMA32(p1, t3, acc[7]); } \
    else      { acc[0] = MFMA32(t0, p0, acc[0]); acc[1] = MFMA32(t0, p1, acc[1]); acc[2] = MFMA32(t1, p0, acc[2]); acc[3] = MFMA32(t1, p1, acc[3]); \
                acc[4] = MFMA32(t2, p0, acc[4]); acc[5] = MFMA32(t2, p1, acc[5]); acc[6] = MFMA32(t3, p0, acc[6]); acc[7] = MFMA32(t3, p1, acc[7]); } }
  A256_LOADH(0, 0) A256_STH(smem, 0)
  A256_LOADH(0, 1) A256_STH(smem, 1)
  W256_LD(0, 0, w00, w10) W256_LD(0, 1, w01, w11) W256_LD(0, 2, w02, w12) W256_LD(0, 3, w03, w13)
  __syncthreads();
  const int aoff = (tbk * 128 + l32) * LDT + h * 8;
  for (int kt = 0; kt < nk; kt++) {
    const int cur = kt & 1; const int kn = (kt + 1 < nk) ? kt + 1 : last;
    const bf16_t* sp = smem + cur * ATILE_E + aoff;
    bf16_t* nxt = smem + (cur ^ 1) * ATILE_E;
    A256_LOADH(kn, 0)
    MMA256(0, w00, w10) W256_LD(kn, 0, w00, w10)
    MMA256(1, w01, w11) W256_LD(kn, 1, w01, w11)
    A256_STH(nxt, 0)
    A256_LOADH(kn, 1)
    MMA256(2, w02, w12) W256_LD(kn, 2, w02, w12)
    MMA256(3, w03, w13) W256_LD(kn, 3, w03, w13)
    A256_STH(nxt, 1)
    __syncthreads();
  }
}
template <class LA>
DI void gemm256(const LA& la, const bf16_t* Wt, const int KS, const int nk, bf16_t* smem, f32x16 (&acc)[8], const bool swap) {
  if (swap) gemm256_ws<true>(la, Wt, KS, nk, smem, acc); else gemm256_ws<false>(la, Wt, KS, nk, smem, acc);
}
#define ZERO_ACC8(a) { _Pragma("unroll") for (int i_ = 0; i_ < 8; i_++) _Pragma("unroll") for (int r_ = 0; r_ < 16; r_++) a[i_][r_] = 0.f; }
DI bool tile_sched256(int bid, int it, int NT, int PW, int& mt, int& nt) {
  const int x = bid & 7, slot = bid >> 3, nslot = gridDim.x >> 3;
  const int j = slot + it * nslot;
  if (j >= 32 * NT) return false;
  const int ppan = 32 * PW; const int panel = j / ppan, rem = j - panel * ppan;
  const int ml = rem / PW; nt = panel * PW + (rem - ml * PW); mt = x * 32 + ml;
  return true;
}
#define SW_FOR_TOK(j) _Pragma("unroll") for (int j = 0; j < 4; j++)
#define SW_FOR_FEAT(i, rq) _Pragma("unroll") for (int i = 0; i < 2; i++) _Pragma("unroll") for (int rq = 0; rq < 4; rq++)
#define SWV(i, j, e) acc[(i) * 4 + (j)][e]
#define NS_FOR_FEAT(j) _Pragma("unroll") for (int j = 0; j < 2; j++)
#define NS_FOR_TOK(i, rq) _Pragma("unroll") for (int i = 0; i < 4; i++) _Pragma("unroll") for (int rq = 0; rq < 4; rq++)
#define NSV(i, j, e) acc[(i) * 2 + (j)][e]
constexpr int EPLD = 136;
constexpr int TPLD = 264;
#define STAGE_SW(scaled_) SW_FOR_TOK(j) { const int tl_ = wn * 128 + j * 32 + l32; const float rs_ = (scaled_) ? s_rs[tl_] : 1.f; \
    SW_FOR_FEAT(i, rq) { const int c_ = wm * 64 + i * 32 + 8 * rq + 4 * h; \
      *(uint2*)(smem + tl_ * EPLD + c_) = make_uint2(pk2(SWV(i, j, 4 * rq) * rs_, SWV(i, j, 4 * rq + 1) * rs_), pk2(SWV(i, j, 4 * rq + 2) * rs_, SWV(i, j, 4 * rq + 3) * rs_)); } }
#define STAGE_NS() NS_FOR_FEAT(j) { const int c_ = wn * 64 + j * 32 + l32; \
    NS_FOR_TOK(i, rq) { const int tl_ = wm * 128 + i * 32 + 8 * rq + 4 * h; \
      *(uint2*)(smem + c_ * TPLD + tl_) = make_uint2(pk2(NSV(i, j, 4 * rq) * s_rs[tl_], NSV(i, j, 4 * rq + 1) * s_rs[tl_ + 1]), pk2(NSV(i, j, 4 * rq + 2) * s_rs[tl_ + 2], NSV(i, j, 4 * rq + 3) * s_rs[tl_ + 3])); } }
DI void rows_out(const bf16_t* smem, bf16_t* dst, int ldd, int tid) {
#pragma unroll 8
  for (int k = 0; k < 16; k++) { const int c = tid + 256 * k; const int row = c >> 4, ch = c & 15;
    *(uint4*)(dst + (size_t)row * ldd + ch * 8) = *(const uint4*)(smem + row * EPLD + ch * 8); }
}
DI void rows_out_tiled(const bf16_t* smem, bf16_t* buf, size_t t0, int f0, int KT, int tid) {
#pragma unroll 8
  for (int k = 0; k < 16; k++) { const int c = tid + 256 * k; const int ch = c & 7, row = (c >> 3) & 255, fh = c >> 11;
    *(uint4*)(buf + tix(t0 + row, f0 + fh * 64 + ch * 8, KT)) = *(const uint4*)(smem + row * EPLD + fh * 64 + ch * 8); }
}

template <class F>
DI void cvt_task(bf16_t* dst, int N, int K, F f, int gt, int gs) {
  const int nu = N * (K >> 3);
  for (int u = gt; u < nu; u += gs) {
    int n = u % N, kc = u / N; float v[8];
#pragma unroll
    for (int j = 0; j < 8; j++) v[j] = f(kc * 8 + j, n);
    *(uint4*)(dst + (((size_t)(n >> 5) * (K >> 4) + (kc >> 1)) * 64 + (kc & 1) * 32 + (n & 31)) * 8) = make_uint4(pk2(v[0], v[1]), pk2(v[2], v[3]), pk2(v[4], v[5]), pk2(v[6], v[7]));
  }
}

DI void ph_prelude(const Params& P) {
  const int tid0 = otid();
  const int gt = obid() * NTHR + tid0, gs = gridDim.x * NTHR;
  char* ws = P.ws;
  if (gt < 64) ((unsigned*)(ws + OFF_CNT))[gt] = 0u;
  { const float* w = P.w_in_e; const float* gp = P.g_pre;
    cvt_task((bf16_t*)(ws + OFF_WINE), 3584, 1024, [=](int k, int n) { return w[(size_t)k * 3584 + n] * gp[k] * (n < 512 ? 0.125f * LOG2E : 1.f); }, gt, gs); }
  { const float* w = P.w_out_e; cvt_task((bf16_t*)(ws + OFF_WOUTE), 1024, 1024, [=](int k, int n) { return w[(size_t)k * 1024 + n]; }, gt, gs); }
  { const float* w = P.w_out_o; cvt_task((bf16_t*)(ws + OFF_WOUTO), 1024, 1024, [=](int k, int n) { return w[(size_t)k * 1024 + n]; }, gt, gs); }
  { const float* w = P.w_ple_gate; cvt_task((bf16_t*)(ws + OFF_WG0), 1024, 1024, [=](int k, int n) { return w[(size_t)k * 1024 + n]; }, gt, gs); }
  { const float* w = P.w_ple_gate + 1024 * 1024; cvt_task((bf16_t*)(ws + OFF_WG1), 1024, 1024, [=](int k, int n) { return w[(size_t)k * 1024 + n]; }, gt, gs); }
  { const float* w = P.w_ple; cvt_task((bf16_t*)(ws + OFF_WE0), 1024, 256, [=](int k, int n) { return w[(size_t)k * 1024 + n]; }, gt, gs); }
  { const float* w = P.w_ple + 256 * 1024; cvt_task((bf16_t*)(ws + OFF_WE1), 1024, 256, [=](int k, int n) { return w[(size_t)k * 1024 + n]; }, gt, gs); }
  {
    const float* w = P.w_in_o; const float* gp = P.g_pre + 1024;
    cvt_task((bf16_t*)(ws + OFF_WINO), 1024, 1024, [=](int k, int n) {
      int col; if (n < 384) col = n; else if (n < 512) { col = (n < 416) ? n : -1; } else col = 416 + (n - 512);
      return col < 0 ? 0.f : w[(size_t)k * 1952 + col] * gp[k]; }, gt, gs);
    cvt_task((bf16_t*)(ws + OFF_WINO) + (size_t)2048 * 1024, 512, 1024, [=](int k, int n) { return w[(size_t)k * 1952 + 1440 + n] * gp[k]; }, gt, gs);
    bf16_t* dst = (bf16_t*)(ws + OFF_WINO) + (size_t)1024 * 1024;
    for (int u = gt; u < 1024 * 128; u += gs) {
      int nn = u & 1023, kcb = u >> 10; int part = nn >> 9, ch = nn & 511, gi = ch >> 7, kc_ = ch & 127;
      float a[8];
#pragma unroll
      for (int j = 0; j < 8; j++) a[j] = 0.f;
      const float* wp = w + 928 + gi * 128 + (size_t)(kcb * 8) * 1952;
      for (int c = 0; c < 128; c++) {
        float f = (float)((kc_ * c) & 127) * (1.f / 128.f);
        float tr = part ? __builtin_amdgcn_sinf(f) : __builtin_amdgcn_cosf(f);
#pragma unroll
        for (int j = 0; j < 8; j++) a[j] += wp[(size_t)j * 1952 + c] * tr;
      }
#pragma unroll
      for (int j = 0; j < 8; j++) a[j] *= gp[kcb * 8 + j];
      *(uint4*)(dst + (((size_t)(nn >> 5) * 64 + (kcb >> 1)) * 64 + (kcb & 1) * 32 + (nn & 31)) * 8) = make_uint4(pk2(a[0], a[1]), pk2(a[2], a[3]), pk2(a[4], a[5]), pk2(a[6], a[7]));
    }
  }
  { const float* w = P.w_uq; const float* gq = P.q_norm_g; const float sc = 0.10206207261596577f * LOG2E;
    cvt_task((bf16_t*)(ws + OFF_WUQ), 768, 256, [=](int k, int n) { return w[(size_t)k * 768 + n] * gq[k] * sc; }, gt, gs); }
  { const float* w = P.w_ukv; const float* gk = P.kv_norm_g;
    cvt_task((bf16_t*)(ws + OFF_WUKV), 1024, 128, [=](int k, int n) {
      int col = (n < 512) ? ((n >> 6) * 128 + (n & 63)) : (((n - 512) >> 6) * 128 + 64 + (n & 63));
      return w[(size_t)k * 1024 + col] * gk[k]; }, gt, gs); }
  { float* rc = (float*)(ws + OFF_ROPEC); float* rsn = (float*)(ws + OFF_ROPES);
    for (int u = gt; u < 8192 * 16; u += gs) {
      int pos = u >> 4, i = u & 15;
      float fr = P.inv_freq[0];
#pragma unroll
      for (int k = 1; k < 16; k++) fr = (i == k) ? P.inv_freq[k] : fr;
      float ang = (float)pos * fr;
      double t = (double)ang * 0.15915494309189535; t -= floor(t);
      float f = (float)t;
      rc[u] = __builtin_amdgcn_cosf(f); rsn[u] = __builtin_amdgcn_sinf(f);
    } }
}

DI void xprep_rows(const Params& P, int g, int t0, int nrows, int wave, int nwaves, int lane) {
  const float* x = g ? P.x1 : P.x0;
  float* rs = (float*)(P.ws + OFF_RSIN) + g * TOK;
  bf16_t* xb = (bf16_t*)(P.ws + (g ? OFF_XB1 : OFF_X2B));
  for (int r = wave; r < nrows; r += nwaves) {
    const int t = t0 + r;
    const float* xr = x + (size_t)t * 1024;
    float s = 0.f;
#pragma unroll
    for (int k = 0; k < 4; k++) {
      const int f = (k * 64 + lane) * 4;
      float4 v = ldg_nt(xr + f); s += v.x * v.x + v.y * v.y + v.z * v.z + v.w * v.w;
      store4(xb + tix(t, f, 16), v.x, v.y, v.z, v.w);
    }
    s = wave_sum(s);
    if (lane == 0) rs[t] = rsqrtf(s * (1.f / 1024.f) + EPS);
  }
}
DI void ph_xprep(const Params& P, int g) {
  const int tid0 = otid();
  xprep_rows(P, g, 0, TOK, (obid() * NTHR + tid0) >> 6, (gridDim.x * NTHR) >> 6, tid0 & 63);
}

DI void ph_in_e(const Params& P, int g, bf16_t* smem, float* s_rs) {
  WAVE_IDS
  const int S = g ? 4096 : 8192;
  const bf16_t* xb = (const bf16_t*)(P.ws + (g ? OFF_XB1 : OFF_X2B));
  const float* rs_in = (const float*)(P.ws + OFF_RSIN) + g * TOK;
  const bf16_t* W = (const bf16_t*)(P.ws + OFF_WINE);
  bf16_t* L = (bf16_t*)(P.ws + OFF_L);
  for (int it = 0;; it++) {
    int mt, nt; if (!tile_sched256(bid, it, 28, 7, mt, nt)) break;
    const int m0 = mt * 256, n0 = nt * 128; const int split = nt >> 2, cin = (nt & 3) * 128;
    __syncthreads();
    s_rs[tid] = rs_in[m0 + tid];
    f32x16 acc[8]; ZERO_ACC8(acc)
    LoadTile256 la{xb + (size_t)(2 * mt) * 16 * 8192, 16 * 8192};
    const bool swap = (split != 2);
    gemm256(la, W + (size_t)n0 * 1024, 64, 16, smem, acc, swap);
    if (swap) {
      STAGE_SW(true)
      __syncthreads();
      rows_out(smem, L + (size_t)split * 32 * ME + (size_t)m0 * 512 + cin, 512, tid);
    } else {
      STAGE_NS()
      __syncthreads();
      bf16_t* Vt = L + L0_VT; const int b = m0 / S, s0 = m0 % S;
#pragma unroll 8
      for (int k = 0; k < 16; k++) { const int c = tid + 256 * k; const int q = c & 31, f = c >> 5; const int cc = cin + f;
        *(uint4*)(Vt + ((size_t)(b * 8 + (cc >> 6)) * 64 + (cc & 63)) * S + s0 + q * 8) = *(const uint4*)(smem + f * TPLD + q * 8); }
    }
  }
}

constexpr int RPB_OFF_E = 62 * 512;
DI void na_item(const Params& P, int g, int item, bf16_t* smem) {
  const int tid = otid(), lane = tid & 63, w = tid >> 6, q = lane & 15, gq = lane >> 4;
  const int S = g ? 4096 : 8192; const int rows = S >> 6;
  const int hh = item & 7; const int br = item >> 3; const int r = br % rows, b = br / rows;
  const bf16_t* s_rpb = smem + RPB_OFF_E + hh * 465;
  const bf16_t* L = (const bf16_t*)(P.ws + OFF_L);
  const bf16_t* Qb = L + L0_Q; const bf16_t* Kb = L + L0_K; const bf16_t* Vt = L + L0_VT; const bf16_t* Ga = L + L0_GA;
  bf16_t* cat = (bf16_t*)(P.ws + OFF_CAT);
  int rs_ = r - 4; rs_ = rs_ < 0 ? 0 : rs_; rs_ = rs_ > rows - 8 ? rows - 8 : rs_;
  const int cb = (w == 0) ? 0 : (w == 1) ? 8 : (w == 2) ? 24 : 32;
  const int c = 16 * w + q; int cs = c - 8; cs = cs < 0 ? 0 : cs; cs = cs > 48 ? 48 : cs;
  const size_t tb = (size_t)b * S;
  const bf16_t* qp = Qb + (tb + r * 64 + c) * 512 + hh * 64 + gq * 8;
  const bf16x8 qf0 = *(const bf16x8*)qp, qf1 = *(const bf16x8*)(qp + 32);
  f32x4 sc[8][2];
#pragma unroll
  for (int kr = 0; kr < 8; kr++)
#pragma unroll
    for (int T = 0; T < 2; T++) {
      const bf16_t* kp = Kb + (tb + (rs_ + kr) * 64 + cb + 8 * (q >> 2) + 4 * T + (q & 3)) * 512 + hh * 64 + gq * 8;
      bf16x8 k0 = *(const bf16x8*)kp, k1 = *(const bf16x8*)(kp + 32);
      f32x4 a = {0.f, 0.f, 0.f, 0.f};
      a = MFMA16(k0, qf0, a); a = MFMA16(k1, qf1, a);
      sc[kr][T] = a;
    }
  float mx = -1e30f;
#pragma unroll
  for (int kr = 0; kr < 8; kr++)
#pragma unroll
    for (int T = 0; T < 2; T++)
#pragma unroll
      for (int i = 0; i < 4; i++) {
        const int kc = cb + 8 * gq + 4 * T + i;
        const bool valid = (kc >= cs) && (kc < cs + 16);
        const int dr = rs_ + kr - r + 7, dc = kc - c + 15;
        const float bias = bf2f_(s_rpb[valid ? dr * 31 + dc : 0]);
        const float v = valid ? sc[kr][T][i] + bias : -1e30f;
        sc[kr][T][i] = v; mx = fmaxf(mx, v);
      }
  mx = fmaxf(mx, __shfl_xor(mx, 16)); mx = fmaxf(mx, __shfl_xor(mx, 32));
  float sum = 0.f;
#pragma unroll
  for (int kr = 0; kr < 8; kr++)
#pragma unroll
    for (int T = 0; T < 2; T++)
#pragma unroll
      for (int i = 0; i < 4; i++) { float p = __builtin_amdgcn_exp2f(sc[kr][T][i] - mx); sc[kr][T][i] = p; sum += p; }
  sum += __shfl_xor(sum, 16); sum += __shfl_xor(sum, 32);
  f32x4 o[4];
#pragma unroll
  for (int m = 0; m < 4; m++) o[m] = f32x4{0.f, 0.f, 0.f, 0.f};
#pragma unroll
  for (int kr = 0; kr < 8; kr++) {
    uint4 pu = make_uint4(pk2(sc[kr][0][0], sc[kr][0][1]), pk2(sc[kr][0][2], sc[kr][0][3]), pk2(sc[kr][1][0], sc[kr][1][1]), pk2(sc[kr][1][2], sc[kr][1][3]));
    const bf16x8 pb = __builtin_bit_cast(bf16x8, pu);
#pragma unroll
    for (int m = 0; m < 4; m++) {
      const bf16_t* vp = Vt + ((size_t)(b * 8 + hh) * 64 + m * 16 + q) * S + (rs_ + kr) * 64 + cb + 8 * gq;
      const bf16x8 av = *(const bf16x8*)vp;
      o[m] = MFMA16(av, pb, o[m]);
    }
  }
  const float inv = 1.f / sum;
  const size_t tq = tb + r * 64 + c;
#pragma unroll
  for (int m = 0; m < 4; m++) {
    const int dv = hh * 64 + m * 16 + 4 * gq;
    uint2 gu = *(const uint2*)(Ga + tq * 512 + dv);
    store4(cat + tix(tq, dv, 16), o[m][0] * inv * siluf_(bflo(gu.x)), o[m][1] * inv * siluf_(bfhi(gu.x)),
           o[m][2] * inv * siluf_(bflo(gu.y)), o[m][3] * inv * siluf_(bfhi(gu.y)));
  }
}

DI void conv_item(const Params& P, int g, int item, bf16_t* smem) {
  const int tid = otid(), lane = tid & 63, w = tid >> 6;
  const int S = g ? 4096 : 8192;
  const int t0 = item * 32; const int b = t0 / S, s0 = t0 % S;
  const bf16_t* L = (const bf16_t*)(P.ws + OFF_L);
  const bf16_t* Ua = L + L0_UA; const bf16_t* Ub = L + L0_UB; const bf16_t* Gb = L + L0_GB;
  bf16_t* cat = (bf16_t*)(P.ws + OFF_CAT);
  const size_t tb = (size_t)b * S;
  __syncthreads();
  for (int c0 = tid; c0 < 62 * 64; c0 += 4 * NTHR) {
    uint4 av[4], bv[4];
#pragma unroll
    for (int u = 0; u < 4; u++) {
      const int c = c0 + u * NTHR; const int row = c >> 6, cc = c & 63; const int s = s0 - 15 + row;
      av[u] = make_uint4(0, 0, 0, 0); bv[u] = make_uint4(0, 0, 0, 0);
      if (c < 62 * 64 && s >= 0 && s < S) { av[u] = *(const uint4*)(Ua + (tb + s) * 512 + cc * 8); bv[u] = *(const uint4*)(Ub + (tb + s) * 512 + cc * 8); }
    }
#pragma unroll
    for (int u = 0; u < 4; u++) {
      const int c = c0 + u * NTHR; const int row = c >> 6, cc = c & 63;
      const uint4 a = av[u], bb = bv[u];
      uint4 o;
      o.x = pk2(bflo(a.x) * sigmoidf_(bflo(bb.x)), bfhi(a.x) * sigmoidf_(bfhi(bb.x)));
      o.y = pk2(bflo(a.y) * sigmoidf_(bflo(bb.y)), bfhi(a.y) * sigmoidf_(bfhi(bb.y)));
      o.z = pk2(bflo(a.z) * sigmoidf_(bflo(bb.z)), bfhi(a.z) * sigmoidf_(bfhi(bb.z)));
      o.w = pk2(bflo(a.w) * sigmoidf_(bflo(bb.w)), bfhi(a.w) * sigmoidf_(bfhi(bb.w)));
      if (c < 62 * 64) *(uint4*)(smem + row * 512 + cc * 8) = o;
    }
  }
  __syncthreads();
  {
    float wx[31], wy[31];
#pragma unroll
    for (int j = 0; j < 31; j++) { float2 v = *(const float2*)(P.dw_w + j * 512 + 2 * tid); wx[j] = v.x; wy[j] = v.y; }
    const float2 bias = *(const float2*)(P.dw_b + 2 * tid);
    unsigned* su = (unsigned*)smem;
    for (int tg = 0; tg < 4; tg++) {
      float ax[8], ay[8];
#pragma unroll
      for (int k = 0; k < 8; k++) { ax[k] = bias.x; ay[k] = bias.y; }
#pragma unroll
      for (int rr = 0; rr < 38; rr++) {
        const unsigned u = su[(tg * 8 + rr) * 256 + tid];
        const float vx = bflo(u), vy = bfhi(u);
#pragma unroll
        for (int k = 0; k < 8; k++) {
          const int j = rr - k;
          if (j >= 0 && j <= 30) { ax[k] += vx * wx[j]; ay[k] += vy * wy[j]; }
        }
      }
#pragma unroll
      for (int k = 0; k < 8; k++) su[(tg * 8 + k) * 256 + tid] = pk2(ax[k], ay[k]);
    }
  }
  __syncthreads();
  for (int k = 0; k < 8; k++) {
    const int tl = w * 8 + k;
    uint4 u = *(const uint4*)(smem + tl * 512 + lane * 8);
    float v[8] = {bflo(u.x), bfhi(u.x), bflo(u.y), bfhi(u.y), bflo(u.z), bfhi(u.z), bflo(u.w), bfhi(u.w)};
    float s1 = 0.f, s2 = 0.f;
#pragma unroll
    for (int j = 0; j < 8; j++) { s1 += v[j]; s2 += v[j] * v[j]; }
    s1 = wave_sum(s1); s2 = wave_sum(s2);
    const float mu = s1 * (1.f / 512.f); float var = s2 * (1.f / 512.f) - mu * mu; var = var < 0.f ? 0.f : var;
    const float rstd = rsqrtf(var + EPS);
    const size_t tq = tb + s0 + tl;
    const uint4 gu = *(const uint4*)(Gb + tq * 512 + lane * 8);
    const float gg[8] = {bflo(gu.x), bfhi(gu.x), bflo(gu.y), bfhi(gu.y), bflo(gu.z), bfhi(gu.z), bflo(gu.w), bfhi(gu.w)};
    const float4 lg0 = *(const float4*)(P.cln_g + lane * 8), lg1 = *(const float4*)(P.cln_g + lane * 8 + 4);
    const float4 lb0 = *(const float4*)(P.cln_b + lane * 8), lb1 = *(const float4*)(P.cln_b + lane * 8 + 4);
    const float lg[8] = {lg0.x, lg0.y, lg0.z, lg0.w, lg1.x, lg1.y, lg1.z, lg1.w};
    const float lb[8] = {lb0.x, lb0.y, lb0.z, lb0.w, lb1.x, lb1.y, lb1.z, lb1.w};
    float ov[8];
#pragma unroll
    for (int j = 0; j < 8; j++) { float y = (v[j] - mu) * rstd * lg[j] + lb[j]; ov[j] = siluf_(y) * siluf_(gg[j]); }
    *(uint4*)(cat + tix(tq, 512 + lane * 8, 16)) = make_uint4(pk2(ov[0], ov[1]), pk2(ov[2], ov[3]), pk2(ov[4], ov[5]), pk2(ov[6], ov[7]));
  }
}

DI void ph_mix_e(const Params& P, int g, bf16_t* smem, int* s_item, int rep) {
  const int nconv = TOK / 32, nna = 8192;
  unsigned* word = (unsigned*)(P.ws + OFF_CNT) + 32 + g * 2 + rep;
  const int tid = otid();
  __syncthreads();
  for (int i = tid; i < 8 * 465; i += NTHR) smem[RPB_OFF_E + i] = (bf16_t)(pk2(P.rpb[i] * LOG2E, 0.f) & 0xffffu);
  if (tid == 0) { const unsigned old = atomicAdd(word, 1u); *s_item = (old < (unsigned)(nconv + nna)) ? (int)old : -1; }
  __syncthreads();
  for (;;) {
    const int it = *s_item;
    if (it < 0) break;
    unsigned nxt = 0u;
    if (tid == 0) nxt = atomicAdd(word, 1u);
    const int part = (rep == 0) ? 3 : MIXE_REP_PART;
    if (it < nconv) { if (part & 1) conv_item(P, g, it, smem); } else { if (part & 2) na_item(P, g, it - nconv, smem); }
    __syncthreads();
    if (tid == 0) *s_item = (nxt < (unsigned)(nconv + nna)) ? (int)nxt : -1;
    __syncthreads();
  }
}

DI void ph_out(const Params& P, int layer, bf16_t* smem) {
  WAVE_IDS
  const bf16_t* cat = (const bf16_t*)(P.ws + OFF_CAT);
  const bf16_t* W = (const bf16_t*)(P.ws + (layer ? OFF_WOUTO : OFF_WOUTE));
  bf16_t* ob = (bf16_t*)(P.ws + OFF_L) + (layer ? L1_OB : L0_OB);
  float* ss = (float*)(P.ws + OFF_SS);
  const float* s_rs = nullptr;
  for (int it = 0;; it++) {
    int mt, nt; if (!tile_sched256(bid, it, 8, 8, mt, nt)) break;
    const int m0 = mt * 256, n0 = nt * 128;
    __syncthreads();
    f32x16 acc[8]; ZERO_ACC8(acc)
    LoadTile256 la{cat + (size_t)(2 * mt) * 16 * 8192, 16 * 8192};
    gemm256_ws<true>(la, W + (size_t)n0 * 1024, 64, 16, smem, acc);
    SW_FOR_TOK(j) {
      const int tl = wn * 128 + j * 32 + l32; const size_t tg = (size_t)m0 + tl;
      float sq = 0.f;
      SW_FOR_FEAT(i, rq) {
        const int c = n0 + wm * 64 + i * 32 + 8 * rq + 4 * h;
        const float a0 = SWV(i, j, 4 * rq), a1 = SWV(i, j, 4 * rq + 1), a2 = SWV(i, j, 4 * rq + 2), a3 = SWV(i, j, 4 * rq + 3);
        sq += a0 * a0 + a1 * a1 + a2 * a2 + a3 * a3; (void)c;
      }
      sq += __shfl_xor(sq, 32);
      if (h == 0) ss[tg * 16 + nt * 2 + wm] = sq;
    }
    STAGE_SW(false)
    __syncthreads();
    rows_out(smem, ob + (size_t)m0 * 1024 + n0, 1024, tid);
  }
}

DI void ph_resid(const Params& P, int g, int layer) {
  const int tid0 = otid(); const int lane = tid0 & 63;
  const int wid = (obid() * NTHR + tid0) >> 6, nw = (gridDim.x * NTHR) >> 6;
  const float* xs = g ? P.x1 : P.x0;
  const bf16_t* x2b = (const bf16_t*)(P.ws + OFF_X2B);
  const bf16_t* ob = (const bf16_t*)(P.ws + OFF_L) + (layer ? L1_OB : L0_OB);
  bf16_t* x1b = (bf16_t*)(P.ws + OFF_L) + (layer ? L1_X1B : L0_X1B);
  const float* ss = (const float*)(P.ws + OFF_SS);
  const float* gp = P.g_post + layer * 1024;
  const float* pp = (g ? P.p1 : P.p0) + (size_t)layer * TOK * 256;
  bf16_t* pb = (bf16_t*)(P.ws + OFF_L) + (layer ? L1_VT : L0_VT);
  for (int t = wid; t < TOK; t += nw) {
    { const float4 pv = ldg_nt(pp + (size_t)t * 256 + lane * 4); store4(pb + tix(t, lane * 4, 4), pv.x, pv.y, pv.z, pv.w); }
    float s = (lane < 16) ? ss[(size_t)t * 16 + lane] : 0.f;
    s = wave_sum(s);
    const float rs = rsqrtf(s * (1.f / 1024.f) + EPS);
#pragma unroll
    for (int k = 0; k < 4; k++) {
      const int f = (k * 64 + lane) * 4;
      float4 xv;
      if (layer == 0) xv = ldg_nt(xs + (size_t)t * 1024 + f);
      else { const uint2 xu = *(const uint2*)(x2b + tix(t, f, 16)); xv = make_float4(bflo(xu.x), bfhi(xu.x), bflo(xu.y), bfhi(xu.y)); }
      const uint2 ou = *(const uint2*)(ob + (size_t)t * 1024 + f);
      const float4 gv = *(const float4*)(gp + f);
      store4(x1b + tix(t, f, 16), xv.x + bflo(ou.x) * rs * gv.x, xv.y + bfhi(ou.x) * rs * gv.y, xv.z + bflo(ou.y) * rs * gv.z, xv.w + bfhi(ou.y) * rs * gv.w);
    }
  }
}

DI void ph_ple(const Params& P, int g, int layer, bf16_t* smem) {
  WAVE_IDS
  const bf16_t* x1b = (const bf16_t*)(P.ws + OFF_L) + (layer ? L1_X1B : L0_X1B);
  const bf16_t* Wg = (const bf16_t*)(P.ws + (layer ? OFF_WG1 : OFF_WG0));
  const bf16_t* We = (const bf16_t*)(P.ws + (layer ? OFF_WE1 : OFF_WE0));
  const bf16_t* pb = (const bf16_t*)(P.ws + OFF_L) + (layer ? L1_VT : L0_VT);
  float* y = g ? P.y1 : P.y0;
  bf16_t* x2b = (bf16_t*)(P.ws + OFF_X2B);
  float* ssx = (float*)(P.ws + OFF_SSX);
  const float* s_rs = nullptr;
  for (int it = 0;; it++) {
    int mt, nt; if (!tile_sched256(bid, it, 8, 8, mt, nt)) break;
    const int m0 = mt * 256, n0 = nt * 128;
    __syncthreads();
    f32x16 acc[8]; ZERO_ACC8(acc)
    { LoadTile256 la{pb + (size_t)(2 * mt) * 4 * 8192, 4 * 8192}; gemm256_ws<true>(la, We + (size_t)n0 * 256, 16, 4, smem, acc); }
    STAGE_SW(false)
    __syncthreads();
    rows_out_tiled(smem, x2b, (size_t)m0, n0, 16, tid);
    __syncthreads();
    ZERO_ACC8(acc)
    { LoadTile256 la{x1b + (size_t)(2 * mt) * 16 * 8192, 16 * 8192}; gemm256_ws<true>(la, Wg + (size_t)n0 * 1024, 64, 16, smem, acc); }
    SW_FOR_TOK(j) { const int tl_ = wn * 128 + j * 32 + l32;
      SW_FOR_FEAT(i, rq) { const int c_ = wm * 64 + i * 32 + 8 * rq + 4 * h;
        *(uint2*)(smem + tl_ * EPLD + c_) = make_uint2(pk2(sigmoidf_(SWV(i, j, 4 * rq)), sigmoidf_(SWV(i, j, 4 * rq + 1))), pk2(sigmoidf_(SWV(i, j, 4 * rq + 2)), sigmoidf_(SWV(i, j, 4 * rq + 3)))); } }
    __syncthreads();
#pragma unroll 8
    for (int k = 0; k < 16; k++) {
      const int c = tid + 256 * k; const int ch8 = c & 7, row = (c >> 3) & 255, fh = c >> 11;
      const int f = fh * 64 + ch8 * 8; const size_t tg = (size_t)m0 + row;
      const uint4 sg = *(const uint4*)(smem + row * EPLD + f);
      bf16_t* ep = x2b + tix(tg, n0 + f, 16);
      const uint4 eu = *(const uint4*)ep;
      float* yp = y + tg * 1024 + n0 + f;
      const uint4 xu = *(const uint4*)(x1b + tix(tg, n0 + f, 16));
      float4 y0 = make_float4(bflo(xu.x), bfhi(xu.x), bflo(xu.y), bfhi(xu.y)), y1 = make_float4(bflo(xu.z), bfhi(xu.z), bflo(xu.w), bfhi(xu.w));
      y0.x += bflo(sg.x) * bflo(eu.x); y0.y += bfhi(sg.x) * bfhi(eu.x); y0.z += bflo(sg.y) * bflo(eu.y); y0.w += bfhi(sg.y) * bfhi(eu.y);
      y1.x += bflo(sg.z) * bflo(eu.z); y1.y += bfhi(sg.z) * bfhi(eu.z); y1.z += bflo(sg.w) * bflo(eu.w); y1.w += bfhi(sg.w) * bfhi(eu.w);
      if (layer != 0) { stg_nt(yp, y0); stg_nt(yp + 4, y1); }
      if (layer == 0) {
        *(uint4*)ep = make_uint4(pk2(y0.x, y0.y), pk2(y0.z, y0.w), pk2(y1.x, y1.y), pk2(y1.z, y1.w));
        float sq = y0.x * y0.x + y0.y * y0.y + y0.z * y0.z + y0.w * y0.w + y1.x * y1.x + y1.y * y1.y + y1.z * y1.z + y1.w * y1.w;
        sq += __shfl_xor(sq, 1); sq += __shfl_xor(sq, 2); sq += __shfl_xor(sq, 4);
        if (ch8 == 0) ssx[tg * 16 + nt * 2 + fh] = sq;
      }
    }
  }
}

DI void ph_in_o(const Params& P, int g, bf16_t* smem, float* s_rs) {
  WAVE_IDS
  const int S = g ? 4096 : 8192;
  const bf16_t* x2b = (const bf16_t*)(P.ws + OFF_X2B);
  const float* ssx = (const float*)(P.ws + OFF_SSX);
  const bf16_t* W = (const bf16_t*)(P.ws + OFF_WINO);
  bf16_t* L = (bf16_t*)(P.ws + OFF_L);
  float* ssq = (float*)(P.ws + OFF_SSQ); float* sskv = (float*)(P.ws + OFF_SSKV);
  const float* ropec = (const float*)(P.ws + OFF_ROPEC); const float* ropes = (const float*)(P.ws + OFF_ROPES);
  for (int it = 0;; it++) {
    int mt, nt; if (!tile_sched256(bid, it, 20, 10, mt, nt)) break;
    const int m0 = mt * 256, n0 = nt * 128;
    __syncthreads();
    {
      const float4* pp = (const float4*)(ssx + (size_t)(m0 + tid) * 16);
      float4 a = pp[0], b = pp[1], c = pp[2], d = pp[3];
      float s = a.x + a.y + a.z + a.w + b.x + b.y + b.z + b.w + c.x + c.y + c.z + c.w + d.x + d.y + d.z + d.w;
      s_rs[tid] = rsqrtf(s * (1.f / 1024.f) + EPS);
    }
    f32x16 acc[8]; ZERO_ACC8(acc)
    LoadTile256 la{x2b + (size_t)(2 * mt) * 16 * 8192, 16 * 8192};
    const bool isY = (nt >= 8 && nt < 16);
    gemm256(la, W + (size_t)n0 * 1024, 64, 16, smem, acc, !isY);
    if (isY) {
      bf16_t* Yt = L + L1_YT;
      STAGE_NS()
      __syncthreads();
      const int b = m0 / S, s0 = m0 % S; const int fbase = (nt - 8) * 128;
#pragma unroll 8
      for (int k = 0; k < 16; k++) { const int c = tid + 256 * k; const int q4 = c & 3, f = (c >> 2) & 127, sblk = c >> 9;
        *(uint4*)(Yt + (((size_t)b * (S >> 5) + (s0 >> 5) + sblk) * 1024 + fbase + f) * 32 + q4 * 8) = *(const uint4*)(smem + f * TPLD + sblk * 32 + q4 * 8); }
    } else if (nt == 3) {
      bf16_t* kr = L + L1_KR;
      if (wm == 0) {
        SW_FOR_TOK(j) {
          const int tl = wn * 128 + j * 32 + l32; const size_t tg = (size_t)m0 + tl; const float rs = s_rs[tl];
          const int pos = (int)(tg % S);
#pragma unroll
          for (int rq = 0; rq < 2; rq++) {
            const int fi = 8 * rq + 4 * h;
            const float4 cv = *(const float4*)(ropec + pos * 16 + fi), sv = *(const float4*)(ropes + pos * 16 + fi);
            const float a0 = SWV(0, j, 4 * rq) * rs, a1 = SWV(0, j, 4 * rq + 1) * rs, a2 = SWV(0, j, 4 * rq + 2) * rs, a3 = SWV(0, j, 4 * rq + 3) * rs;
            const float b0 = SWV(0, j, 4 * rq + 8) * rs, b1 = SWV(0, j, 4 * rq + 9) * rs, b2 = SWV(0, j, 4 * rq + 10) * rs, b3 = SWV(0, j, 4 * rq + 11) * rs;
            store4(kr + tg * 32 + fi, a0 * cv.x - b0 * sv.x, a1 * cv.y - b1 * sv.y, a2 * cv.z - b2 * sv.z, a3 * cv.w - b3 * sv.w);
            store4(kr + tg * 32 + 16 + fi, b0 * cv.x + a0 * sv.x, b1 * cv.y + a1 * sv.y, b2 * cv.z + a2 * sv.z, b3 * cv.w + a3 * sv.w);
          }
        }
      }
    } else {
      bf16_t* dst; int ldd, cin;
      if (nt < 2) { dst = L + L1_CQ; ldd = 256; cin = nt * 128; }
      else if (nt == 2) { dst = L + L1_CKV; ldd = 128; cin = 0; }
      else if (nt < 8) { dst = L + L1_GC; ldd = 512; cin = (nt - 4) * 128; }
      else { dst = L + L1_GD; ldd = 512; cin = (nt - 16) * 128; }
      SW_FOR_TOK(j) {
        const int tl = wn * 128 + j * 32 + l32; const size_t tg = (size_t)m0 + tl; const float rs = s_rs[tl];
        float sq = 0.f;
        SW_FOR_FEAT(i, rq) {
          const int c = cin + wm * 64 + i * 32 + 8 * rq + 4 * h;
          const float a0 = SWV(i, j, 4 * rq) * rs, a1 = SWV(i, j, 4 * rq + 1) * rs, a2 = SWV(i, j, 4 * rq + 2) * rs, a3 = SWV(i, j, 4 * rq + 3) * rs;
          sq += a0 * a0 + a1 * a1 + a2 * a2 + a3 * a3; (void)c;
        }
        if (nt < 3) {
          sq += __shfl_xor(sq, 32);
          if (h == 0) { if (nt < 2) ssq[tg * 4 + nt * 2 + wm] = sq; else sskv[tg * 2 + wm] = sq; }
        }
      }
      STAGE_SW(true)
      __syncthreads();
      if (nt < 3) rows_out_tiled(smem, dst, (size_t)m0, cin, ldd >> 6, tid);
      else rows_out(smem, dst + (size_t)m0 * ldd + cin, ldd, tid);
    }
  }
}

DI void yt_fold(const Params& P, int g) {
  const int S = g ? 4096 : 8192; const int B = g ? 16 : 8;
  const bf16_t* Yt = (const bf16_t*)(P.ws + OFF_L) + L1_YT;
  bf16_t* Yf = (bf16_t*)(P.ws + OFF_YTF);
  const int gt = obid() * NTHR + otid(), gs = gridDim.x * NTHR;
  const int nsb = S >> 6;
  const int total = B * nsb * 1024 * 4;
  for (int u = gt; u < total; u += gs) {
    const int seg = u & 3, f = (u >> 2) & 1023; const int sb = (u >> 12) % nsb, b = (u >> 12) / nsb;
    const int s = sb * 32 + seg * 8;
    const bf16_t* yb = Yt + (size_t)b * S * 1024;
    const uint4 own = *(const uint4*)(yb + ((size_t)sb * 1024 + f) * 32 + seg * 8);
    const int pa = S - s - 8;
    const uint4 ca = *(const uint4*)(yb + ((size_t)(pa >> 5) * 1024 + f) * 32 + (pa & 31));
    float p0 = 0.f;
    if (s != 0) { const int pb = S - s; p0 = bf2f_(*(yb + ((size_t)(pb >> 5) * 1024 + f) * 32 + (pb & 31))); }
    const float sg = (f < 512) ? 1.f : -1.f;
    const float o0 = bflo(own.x) + sg * p0,        o1 = bfhi(own.x) + sg * bfhi(ca.w);
    const float o2 = bflo(own.y) + sg * bflo(ca.w), o3 = bfhi(own.y) + sg * bfhi(ca.z);
    const float o4 = bflo(own.z) + sg * bflo(ca.z), o5 = bfhi(own.z) + sg * bfhi(ca.y);
    const float o6 = bflo(own.w) + sg * bflo(ca.y), o7 = bfhi(own.w) + sg * bfhi(ca.x);
    *(uint4*)(Yf + (((size_t)b * nsb + sb) * 1024 + f) * 32 + seg * 8) = make_uint4(pk2(o0, o1), pk2(o2, o3), pk2(o4, o5), pk2(o6, o7));
  }
}

DI void ph_up(const Params& P, int g, bf16_t* smem, float* s_rs) {
  WAVE_IDS
  const int S = g ? 4096 : 8192;
  bf16_t* L = (bf16_t*)(P.ws + OFF_L);
  const bf16_t* cq = L + L1_CQ; const bf16_t* ckv = L + L1_CKV;
  const float* ssq = (const float*)(P.ws + OFF_SSQ); const float* sskv = (const float*)(P.ws + OFF_SSKV);
  const bf16_t* Wuq = (const bf16_t*)(P.ws + OFF_WUQ); const bf16_t* Wukv = (const bf16_t*)(P.ws + OFF_WUKV);
  const float* ropec = (const float*)(P.ws + OFF_ROPEC); const float* ropes = (const float*)(P.ws + OFF_ROPES);
  for (int it = 0;; it++) {
    int mt, nt14; if (!tile_sched(bid, it, 14, 14, mt, nt14)) break;
    const int m0 = mt * 128;
    __syncthreads();
    f32x16 acc[2][2]; ZERO_ACC(acc)
    if (nt14 < 6) {
      const int nt = nt14, n0 = nt * 128;
      if (tid < 128) { const float4 a = *(const float4*)(ssq + (size_t)(m0 + tid) * 4); s_rs[tid] = rsqrtf((a.x + a.y + a.z + a.w) * (1.f / 256.f) + EPS); }
      LoadTile la{cq + (size_t)mt * 4 * 8192};
      gemm_core_w(la, Wuq + (size_t)n0 * 256, 16, 4, smem, acc, true);
      bf16_t* Qm = L + L1_QM;
#pragma unroll
      for (int j = 0; j < 2; j++) {
        const int tl = wn * 64 + j * 32 + l32; const size_t tg = (size_t)m0 + tl; const float rs = s_rs[tl];
        const int pos = (int)(tg % S);
#pragma unroll
        for (int i = 0; i < 2; i++) {
          const int f0 = n0 + wm * 64 + i * 32;
          if ((f0 % 96) == 64) {
#pragma unroll
            for (int rq = 0; rq < 2; rq++) {
              const int fi = 8 * rq + 4 * h;
              const float4 cv = *(const float4*)(ropec + pos * 16 + fi), sv = *(const float4*)(ropes + pos * 16 + fi);
              const float a0 = acc[i][j][4 * rq] * rs, a1 = acc[i][j][4 * rq + 1] * rs, a2 = acc[i][j][4 * rq + 2] * rs, a3 = acc[i][j][4 * rq + 3] * rs;
              const float b0 = acc[i][j][4 * rq + 8] * rs, b1 = acc[i][j][4 * rq + 9] * rs, b2 = acc[i][j][4 * rq + 10] * rs, b3 = acc[i][j][4 * rq + 11] * rs;
              store4(Qm + tg * 768 + f0 + fi, a0 * cv.x - b0 * sv.x, a1 * cv.y - b1 * sv.y, a2 * cv.z - b2 * sv.z, a3 * cv.w - b3 * sv.w);
              store4(Qm + tg * 768 + f0 + 16 + fi, b0 * cv.x + a0 * sv.x, b1 * cv.y + a1 * sv.y, b2 * cv.z + a2 * sv.z, b3 * cv.w + a3 * sv.w);
            }
          } else {
#pragma unroll
            for (int rq = 0; rq < 4; rq++)
              store4(Qm + tg * 768 + f0 + 8 * rq + 4 * h, acc[i][j][4 * rq] * rs, acc[i][j][4 * rq + 1] * rs, acc[i][j][4 * rq + 2] * rs, acc[i][j][4 * rq + 3] * rs);
          }
        }
      }
    } else {
      const int nt = nt14 - 6, n0 = nt * 128;
      if (tid < 128) { const float2 a = *(const float2*)(sskv + (size_t)(m0 + tid) * 2); s_rs[tid] = rsqrtf((a.x + a.y) * (1.f / 128.f) + EPS); }
      LoadTile la{ckv + (size_t)mt * 2 * 8192};
      const bool swap = nt < 4;
      gemm_core_w(la, Wukv + (size_t)n0 * 128, 8, 2, smem, acc, swap);
      if (swap) {
        bf16_t* Kn = L + L1_KN;
#pragma unroll
        for (int j = 0; j < 2; j++) {
          const int tl = wn * 64 + j * 32 + l32; const size_t tg = (size_t)m0 + tl; const float rs = s_rs[tl];
#pragma unroll
          for (int i = 0; i < 2; i++)
#pragma unroll
            for (int rq = 0; rq < 4; rq++)
              store4(Kn + tg * 512 + n0 + wm * 64 + i * 32 + 8 * rq + 4 * h, acc[i][j][4 * rq] * rs, acc[i][j][4 * rq + 1] * rs, acc[i][j][4 * rq + 2] * rs, acc[i][j][4 * rq + 3] * rs);
        }
      } else {
        bf16_t* Vt = L + L1_VT;
#pragma unroll
        for (int j = 0; j < 2; j++) {
          const int c = (nt - 4) * 128 + wn * 64 + j * 32 + l32; const int hh = c >> 6, d = c & 63;
#pragma unroll
          for (int i = 0; i < 2; i++)
#pragma unroll
            for (int rq = 0; rq < 4; rq++) {
              const int tl = wm * 64 + i * 32 + 8 * rq + 4 * h; const int tg = m0 + tl; const int b = tg / S, s = tg % S;
              store4(Vt + ((size_t)(b * 8 + hh) * 64 + d) * S + s, acc[i][j][4 * rq] * s_rs[tl], acc[i][j][4 * rq + 1] * s_rs[tl + 1],
                     acc[i][j][4 * rq + 2] * s_rs[tl + 2], acc[i][j][4 * rq + 3] * s_rs[tl + 3]);
            }
        }
      }
    }
  }
}

constexpr int KLD = 104, VLD = 72;
constexpr int ATT_STAGE_E = 64 * KLD + 64 * VLD;
DI void mla_compute(const bf16_t* sK, const bf16x8 (&qf)[6], f32x16 (&o)[2], f32x16& negm, float& lsum, const bool first, int l32, int h) {
  const bf16_t* sV = sK + 64 * KLD;
  f32x16 s[2];
  const int kp = (l32 & 19) | ((l32 & 4) << 1) | ((l32 & 8) >> 1);
  {
    bf16x8 a0 = *(const bf16x8*)(sK + kp * KLD + h * 8);
    bf16x8 a1 = *(const bf16x8*)(sK + (32 + kp) * KLD + h * 8);
    s[0] = MFMA32(a0, qf[0], negm); s[1] = MFMA32(a1, qf[0], negm);
  }
#pragma unroll
  for (int kk = 1; kk < 6; kk++) {
    bf16x8 a0 = *(const bf16x8*)(sK + kp * KLD + kk * 16 + h * 8);
    bf16x8 a1 = *(const bf16x8*)(sK + (32 + kp) * KLD + kk * 16 + h * 8);
    s[0] = MFMA32(a0, qf[kk], s[0]); s[1] = MFMA32(a1, qf[kk], s[1]);
  }
  float mx = -1e30f;
#pragma unroll
  for (int i = 0; i < 2; i++)
#pragma unroll
    for (int r = 0; r < 16; r++) mx = fmaxf(mx, s[i][r]);
  mx = fmaxf(mx, __shfl_xor(mx, 32));
  if (first || __builtin_amdgcn_ballot_w64(mx > 0.f) != 0ull) {
    const float d = first ? mx : fmaxf(mx, 0.f);
    const float alpha = first ? 0.f : __builtin_amdgcn_exp2f(-d);
#pragma unroll
    for (int i = 0; i < 2; i++)
#pragma unroll
      for (int r = 0; r < 16; r++) { s[i][r] -= d; o[i][r] *= alpha; }
#pragma unroll
    for (int r = 0; r < 16; r++) negm[r] -= d;
    lsum *= alpha;
  }
  float ps = 0.f;
#pragma unroll
  for (int i = 0; i < 2; i++)
#pragma unroll
    for (int r = 0; r < 16; r++) { float p = __builtin_amdgcn_exp2f(s[i][r]); s[i][r] = p; ps += p; }
  lsum += ps;
#pragma unroll
  for (int mt2 = 0; mt2 < 2; mt2++)
#pragma unroll
    for (int st = 0; st < 2; st++) {
      const uint4 pu = make_uint4(pk2(s[mt2][8 * st], s[mt2][8 * st + 1]), pk2(s[mt2][8 * st + 2], s[mt2][8 * st + 3]),
                                  pk2(s[mt2][8 * st + 4], s[mt2][8 * st + 5]), pk2(s[mt2][8 * st + 6], s[mt2][8 * st + 7]));
      const bf16x8 pf = __builtin_bit_cast(bf16x8, pu);
      const int kb = mt2 * 32 + 16 * st + 8 * h;
#pragma unroll
      for (int dt = 0; dt < 2; dt++) {
        const bf16x8 av = *(const bf16x8*)(sV + (dt * 32 + l32) * VLD + kb);
        o[dt] = MFMA32(av, pf, o[dt]);
      }
    }
}
DI void mla_item(const Params& P, int g, int item, bf16_t* smem) {
  WAVE_IDS
  const int S = g ? 4096 : 8192;
  const int nqt = S >> 7;
  const int qt = item % nqt; const int bh = item / nqt; const int hh = bh & 7, b = bh >> 3;
  const bf16_t* L = (const bf16_t*)(P.ws + OFF_L);
  const bf16_t* Qm = L + L1_QM; const bf16_t* Kn = L + L1_KN; const bf16_t* Vt = L + L1_VT; const bf16_t* Kr = L + L1_KR; const bf16_t* Gc = L + L1_GC;
  bf16_t* cat = (bf16_t*)(P.ws + OFF_CAT);
  const size_t tb = (size_t)b * S;
  const size_t tq = tb + qt * 128 + w * 32 + l32;
  bf16x8 qf[6];
#pragma unroll
  for (int kk = 0; kk < 6; kk++) qf[kk] = *(const bf16x8*)(Qm + tq * 768 + hh * 96 + kk * 16 + h * 8);
  f32x16 o[2];
#pragma unroll
  for (int i = 0; i < 2; i++)
#pragma unroll
    for (int r = 0; r < 16; r++) o[i][r] = 0.f;
  float lsum = 0.f;
  f32x16 negm;
#pragma unroll
  for (int r = 0; r < 16; r++) negm[r] = 0.f;
  uint4 rk0, rk1, rk2, rv0, rv1, qk0, qk1, qk2, qv0, qv1;
  const bf16_t* vbase = Vt + (size_t)(b * 8 + hh) * 64 * S;
  const int kc0 = tid, kc1 = tid + 256, kc2 = tid + 512;
  const int kr0 = kc0 / 12, kq0 = kc0 % 12, kr1 = kc1 / 12, kq1 = kc1 % 12, kr2 = kc2 / 12, kq2 = kc2 % 12;
  const int vr0 = tid >> 3, vq0 = tid & 7, vr1 = (tid + 256) >> 3;
#define MLA_KSRC(row, q, k0) ((q) < 8 ? (Kn + (tb + (k0) + (row)) * 512 + hh * 64 + (q) * 8) : (Kr + (tb + (k0) + (row)) * 32 + ((q) - 8) * 8))
#define MLA_GLOAD(kt_, K0, K1, K2, V0, V1) { const int k0_ = (kt_) * 64; \
    K0 = *(const uint4*)MLA_KSRC(kr0, kq0, k0_); K1 = *(const uint4*)MLA_KSRC(kr1, kq1, k0_); K2 = *(const uint4*)MLA_KSRC(kr2, kq2, k0_); \
    V0 = *(const uint4*)(vbase + (size_t)vr0 * S + k0_ + vq0 * 8); V1 = *(const uint4*)(vbase + (size_t)vr1 * S + k0_ + vq0 * 8); }
#define MLA_LSTORE(buf_, K0, K1, K2, V0, V1) { bf16_t* sK_ = smem + (buf_) * ATT_STAGE_E; bf16_t* sV_ = sK_ + 64 * KLD; \
    *(uint4*)(sK_ + kr0 * KLD + kq0 * 8) = K0; *(uint4*)(sK_ + kr1 * KLD + kq1 * 8) = K1; *(uint4*)(sK_ + kr2 * KLD + kq2 * 8) = K2; \
    *(uint4*)(sV_ + vr0 * VLD + vq0 * 8) = V0; *(uint4*)(sV_ + vr1 * VLD + vq0 * 8) = V1; }
  const int nkt = S >> 6; const int lastk = nkt - 1;
  __syncthreads();
  MLA_GLOAD(0, rk0, rk1, rk2, rv0, rv1) MLA_GLOAD(1, qk0, qk1, qk2, qv0, qv1) MLA_LSTORE(0, rk0, rk1, rk2, rv0, rv1)
  __syncthreads();
  for (int kt = 0; kt < nkt; kt += 2) {
    { const int k2 = (kt + 2 < nkt) ? kt + 2 : lastk; MLA_GLOAD(k2, rk0, rk1, rk2, rv0, rv1) }
    mla_compute(smem, qf, o, negm, lsum, kt == 0, l32, h);
    MLA_LSTORE(1, qk0, qk1, qk2, qv0, qv1)
    __syncthreads();
    { const int k3 = (kt + 3 < nkt) ? kt + 3 : lastk; MLA_GLOAD(k3, qk0, qk1, qk2, qv0, qv1) }
    mla_compute(smem + ATT_STAGE_E, qf, o, negm, lsum, false, l32, h);
    MLA_LSTORE(0, rk0, rk1, rk2, rv0, rv1)
    __syncthreads();
  }
  lsum += __shfl_xor(lsum, 32);
  const float inv = 1.f / lsum;
#pragma unroll
  for (int dt = 0; dt < 2; dt++)
#pragma unroll
    for (int rq = 0; rq < 4; rq++) {
      const int dv = hh * 64 + dt * 32 + 8 * rq + 4 * h;
      const uint2 gu = *(const uint2*)(Gc + tq * 512 + dv);
      store4(cat + tix(tq, dv, 16), o[dt][4 * rq] * inv * siluf_(bflo(gu.x)), o[dt][4 * rq + 1] * inv * siluf_(bfhi(gu.x)),
             o[dt][4 * rq + 2] * inv * siluf_(bflo(gu.y)), o[dt][4 * rq + 3] * inv * siluf_(bfhi(gu.y)));
    }
}

DI void dft_mma(const bf16_t* sA, f32x16 (&accP)[2][2], f32x16 (&accQ)[2][2], int moff, int noff) {
  const bf16_t* sB = sA + TILE_E;
#pragma unroll
  for (int kk = 0; kk < 4; kk++) {
    bf16x8 fm0 = *(const bf16x8*)(sB + moff + kk * 16);
    bf16x8 fm1 = *(const bf16x8*)(sB + moff + 32 * LDT + kk * 16);
    bf16x8 fn0 = *(const bf16x8*)(sA + noff + kk * 16);
    bf16x8 fn1 = *(const bf16x8*)(sA + noff + 32 * LDT + kk * 16);
    if (kk < 2) {
      accP[0][0] = MFMA32(fm0, fn0, accP[0][0]); accP[0][1] = MFMA32(fm0, fn1, accP[0][1]);
      accP[1][0] = MFMA32(fm1, fn0, accP[1][0]); accP[1][1] = MFMA32(fm1, fn1, accP[1][1]);
    } else {
      accQ[0][0] = MFMA32(fm0, fn0, accQ[0][0]); accQ[0][1] = MFMA32(fm0, fn1, accQ[0][1]);
      accQ[1][0] = MFMA32(fm1, fn0, accQ[1][0]); accQ[1][1] = MFMA32(fm1, fn1, accQ[1][1]);
    }
  }
}
DI void dft_item(const Params& P, int g, int b, int ml, int ntc, bf16_t* smem) {
  WAVE_IDS
  const int S = g ? 4096 : 8192;
  const int ks0 = ml * 128, n0 = ntc * 128;
  const bf16_t* L = (const bf16_t*)(P.ws + OFF_L);
  const bf16_t* Yt = L + L1_YT; const bf16_t* Gd = L + L1_GD;
  bf16_t* cat = (bf16_t*)(P.ws + OFF_CAT);
  __syncthreads();
  f32x16 accP[2][2], accQ[2][2]; ZERO_ACC(accP) ZERO_ACC(accQ)
  LoadDft la; la.ks0 = ks0; la.S = S; la.invS = 1.f / (float)S; la.init(tid);
  const bf16_t* Yf = (const bf16_t*)(P.ws + OFF_YTF);
  LoadYt lb{Yf + (size_t)b * (S >> 1) * 1024 + (size_t)n0 * 32, S};
  {
    const int nk = S >> 6, last = nk - 1;
    uint4 a00, a01, a02, a03, b00, b01, b02, b03, b10, b11, b12, b13;
    la.load(0, tid, a00, a01, a02, a03); lb.load(0, tid, b00, b01, b02, b03);
    lb.load(1, tid, b10, b11, b12, b13);
    GEMM_ST1(smem, 0, a00, b00) GEMM_ST1(smem, 1, a01, b01) GEMM_ST1(smem, 2, a02, b02) GEMM_ST1(smem, 3, a03, b03)
    __syncthreads();
    const int moff = (wm * 64 + l32) * LDT + h * 8;
    const int noff = (wn * 64 + l32) * LDT + h * 8;
    bf16_t* buf0 = smem; bf16_t* buf1 = smem + 2 * TILE_E;
    for (int kt = 0; kt < nk; kt += 2) {
      { const int k2 = (kt + 2 < nk) ? kt + 2 : last; lb.load(k2, tid, b00, b01, b02, b03); }
      dft_mma(buf0, accP, accQ, moff, noff);
      la.load(kt + 1, tid, a00, a01, a02, a03);
      GEMM_ST1(buf1, 0, a00, b10) GEMM_ST1(buf1, 1, a01, b11) GEMM_ST1(buf1, 2, a02, b12) GEMM_ST1(buf1, 3, a03, b13)
      __syncthreads();
      { const int k3 = (kt + 3 < nk) ? kt + 3 : last; lb.load(k3, tid, b10, b11, b12, b13); }
      dft_mma(buf1, accP, accQ, moff, noff);
      { const int k2 = (kt + 2 < nk) ? kt + 2 : last; la.load(k2, tid, a00, a01, a02, a03); }
      GEMM_ST1(buf0, 0, a00, b00) GEMM_ST1(buf0, 1, a01, b01) GEMM_ST1(buf0, 2, a02, b02) GEMM_ST1(buf0, 3, a03, b03)
      __syncthreads();
    }
  }
  const float scale = rsqrtf((float)S * 128.f);
  const size_t tb = (size_t)b * S;
#pragma unroll
  for (int j = 0; j < 2; j++) {
    const int ks = ks0 + wn * 64 + j * 32 + l32;
    const size_t t1 = tb + ks; const size_t t2 = tb + ((S - ks) & (S - 1));
#pragma unroll
    for (int i = 0; i < 2; i++)
#pragma unroll
      for (int rq = 0; rq < 4; rq++) {
        const int ch = n0 + wm * 64 + i * 32 + 8 * rq + 4 * h;
        const uint2 g1 = *(const uint2*)(Gd + t1 * 512 + ch);
        const bf16_t* yh = Yt + (size_t)b * S * 1024 + ((size_t)(S >> 6) * 1024 + ch) * 32;
        const float sgn = (ks & 1) ? -1.f : 1.f;
        const float p0 = accP[i][j][4 * rq] + sgn * bf2f_(yh[0]), p1 = accP[i][j][4 * rq + 1] + sgn * bf2f_(yh[32]),
                    p2 = accP[i][j][4 * rq + 2] + sgn * bf2f_(yh[64]), p3 = accP[i][j][4 * rq + 3] + sgn * bf2f_(yh[96]);
        const float q0 = accQ[i][j][4 * rq], q1 = accQ[i][j][4 * rq + 1], q2 = accQ[i][j][4 * rq + 2], q3 = accQ[i][j][4 * rq + 3];
        store4(cat + tix(t1, 512 + ch, 16), (p0 + q0) * scale * siluf_(bflo(g1.x)), (p1 + q1) * scale * siluf_(bfhi(g1.x)),
               (p2 + q2) * scale * siluf_(bflo(g1.y)), (p3 + q3) * scale * siluf_(bfhi(g1.y)));
        if (ks != 0) {
          const uint2 g2 = *(const uint2*)(Gd + t2 * 512 + ch);
          store4(cat + tix(t2, 512 + ch, 16), (p0 - q0) * scale * siluf_(bflo(g2.x)), (p1 - q1) * scale * siluf_(bfhi(g2.x)),
                 (p2 - q2) * scale * siluf_(bflo(g2.y)), (p3 - q3) * scale * siluf_(bfhi(g2.y)));
        }
      }
  }
  if (ml == 0) {
    const int ch = tid & 127, part = tid >> 7;
    const bf16_t* yp = Yt + (size_t)b * S * 1024 + (size_t)(n0 + ch) * 32;
    float acc = 0.f;
    for (int sb = part; sb < (S >> 5); sb += 2) {
      const uint4* q = (const uint4*)(yp + (size_t)sb * 1024 * 32);
#pragma unroll
      for (int k = 0; k < 4; k++) { const uint4 u = q[k];
        acc += (bflo(u.x) - bfhi(u.x)) + (bflo(u.y) - bfhi(u.y)) + (bflo(u.z) - bfhi(u.z)) + (bflo(u.w) - bfhi(u.w)); }
    }
    float* red = (float*)smem;
    __syncthreads();
    red[tid] = acc;
    __syncthreads();
    if (part == 0) {
      const float v = (red[tid] + red[tid + 128]) * scale;
      const size_t th = tb + (S >> 1);
      const bf16_t gb = Gd[th * 512 + n0 + ch];
      const float gg = __uint_as_float((unsigned)gb << 16);
      cat[tix(th, 512 + n0 + ch, 16)] = (bf16_t)(pk2(v * siluf_(gg), 0.f) & 0xffffu);
    }
  }
}

DI int queue_take(unsigned* word, bool front, int tot, int* s_item) {
  if (otid() == 0) {
    const unsigned old = atomicAdd(word, front ? 1u : 0x10000u);
    const int f = old & 0xffff, bk = old >> 16;
    *s_item = (f + bk < tot) ? (front ? f : tot - 1 - bk) : -1;
  }
  __syncthreads();
  const int it = *s_item;
  __syncthreads();
  return it;
}
DI void ph_mix_o(const Params& P, int g, bf16_t* smem, int part, int* s_item, int rep) {
  const int S = g ? 4096 : 8192; const int B = g ? 16 : 8;
  const int bid = obid();
  const int x = bid & 7, slot = bid >> 3, nslot = gridDim.x >> 3, half = nslot >> 1;
  const int nqt = S >> 7;
  const int nmt = S >> 8;
  const int nxp = (g == 0) ? 32 : 0;
  const int nm = B * nqt, nd = (B >> 1) * nmt, tot = nm + nxp + nd;
  const bool fwd = slot < half;
  unsigned* word = (unsigned*)(P.ws + OFF_CNT) + (g * 2 + rep) * 8 + x;
  for (;;) {
    const int j = queue_take(word, fwd, tot, s_item);
    if (j < 0) break;
    if (j < nm) {
      if (part & 1) { const int bh = (j / nqt) * 8 + x, qt = j % nqt; mla_item(P, g, bh * nqt + qt, smem); }
    } else if (j < nm + nxp) {
      if (rep == 0) { const int tid0 = otid(); xprep_rows(P, 1, ((j - nm) * 8 + x) * 256, 256, tid0 >> 6, NTHR >> 6, tid0 & 63); }
    } else {
      if (part & 2) { const int jd = j - nm - nxp; const int pair = (jd / nmt) * 8 + x, ml = jd % nmt; dft_item(P, g, pair >> 2, ml, pair & 3, smem); }
    }
  }
}

#define XB_TMO      128
#define XB_XCNT(j)  (256  + 64 * (j))
#define XB_XSUB(j)  (1280 + 64 * (j))
#define XB_XGEN(j)  (2304 + 64 * (j))
#define XB_TOP      3328
#define XB_TOPGEN   3392
#define XCD_BAR_WORDS 3456
#define XB_SPIN_CAP (1u << 18)
#define LAS __attribute__((address_space(3)))

__device__ __forceinline__ unsigned xb_ld(unsigned* p)              { return __hip_atomic_load(p, __ATOMIC_RELAXED, __HIP_MEMORY_SCOPE_AGENT); }
__device__ __forceinline__ unsigned xb_add(unsigned* p, unsigned v) { return __hip_atomic_fetch_add(p, v, __ATOMIC_RELAXED, __HIP_MEMORY_SCOPE_AGENT); }
__device__ __forceinline__ unsigned xb_xcc_id() { return (unsigned)__builtin_amdgcn_s_getreg((3 << 11) | 20) & 0xFu; }
#define XB_SPIN(cond, bar) do { unsigned _sp = 0; while (cond) { __builtin_amdgcn_s_sleep(1); \
    if ((++_sp & 255u) == 0u) { if (xb_ld(&(bar)[XB_TMO])) break; if (_sp > XB_SPIN_CAP) { atomicAdd(&(bar)[XB_TMO], 1u); break; } } } } while (0)

struct XcdBarrier {
    unsigned* bar; unsigned x;
    volatile LAS unsigned* st;
};

__device__ __forceinline__ XcdBarrier xcd_barrier_post(unsigned* bar, volatile LAS unsigned* st) {
    XcdBarrier b; b.bar = bar; b.x = xb_xcc_id(); b.st = st;
    if (threadIdx.x == 0) (void)xb_add(&bar[XB_XCNT(b.x)], 1u);
    return b;
}
__device__ __forceinline__ void xcd_barrier_complete(unsigned* bar, unsigned x, unsigned& nloc, unsigned& nx) {
    const unsigned G = gridDim.x * gridDim.y * gridDim.z;
    unsigned sum, cnt, mine, sp = 0u;
    for (;;) {
        sum = 0u; cnt = 0u; mine = 0u;
#pragma unroll
        for (unsigned j = 0; j < 16; ++j) { const unsigned c = xb_ld(&bar[XB_XCNT(j)]); sum += c; cnt += (c > 0u) ? 1u : 0u; mine = (j == x) ? c : mine; }
        if (sum == G) break;
        __builtin_amdgcn_s_sleep(1);
        if ((++sp & 255u) == 0u) { if (xb_ld(&bar[XB_TMO])) break; if (sp > XB_SPIN_CAP) { atomicAdd(&bar[XB_TMO], 1u); break; } }
    }
    nloc = mine > 0u ? mine : 1u; nx = cnt > 0u ? cnt : 1u;
}

__device__ __forceinline__ void xcd_barrier(const XcdBarrier& b) {
    asm volatile("s_waitcnt vmcnt(0)" ::: "memory");
    __syncthreads();
    if (threadIdx.x == 0) {
        unsigned* bar = b.bar;
        __builtin_amdgcn_s_waitcnt(0);
        unsigned nloc = b.st[0], nx = b.st[1];
        if (nloc == 0u) { xcd_barrier_complete(bar, b.x, nloc, nx); b.st[0] = nloc; b.st[1] = nx; }
        const unsigned old = xb_add(&bar[XB_XSUB(b.x)], 1u);
        const unsigned gen = old / nloc;
        if (old + 1u == (gen + 1u) * nloc) {
            __builtin_amdgcn_fence(__ATOMIC_RELEASE, "agent");
            asm volatile("s_waitcnt vmcnt(0)" ::: "memory");
            const unsigned og = xb_add(&bar[XB_TOP], 1u);
            const unsigned tg = og / nx;
            if (og + 1u == (tg + 1u) * nx) xb_add(&bar[XB_TOPGEN], 1u);
            else XB_SPIN(xb_ld(&bar[XB_TOPGEN]) == tg, bar);
            __builtin_amdgcn_fence(__ATOMIC_ACQUIRE, "agent");
            xb_add(&bar[XB_XGEN(b.x)], 1u);
            asm volatile("s_waitcnt vmcnt(0)" ::: "memory");
        } else {
            XB_SPIN(xb_ld(&bar[XB_XGEN(b.x)]) == gen, bar);
            __builtin_amdgcn_fence(__ATOMIC_ACQUIRE, "agent");
            asm volatile("s_waitcnt vmcnt(0)" ::: "memory");
        }
    }
    __syncthreads();
}


constexpr int NPH = 23;
#ifndef ONLY_SUB
#define ONLY_SUB -1
#endif
#ifndef REP_MASK
#define REP_MASK 0
#endif
#ifndef MIXO_REP_PART
#define MIXO_REP_PART 3
#endif
DI void run_phase(const Params& P, int ph, bf16_t* smem, float* s_rs, int rep, int* s_item) {
  if (ph == 0) { if (ONLY_SUB < 0 || ONLY_SUB == 99) { ph_prelude(P); ph_xprep(P, 0); } return; }
  const int g = (ph - 1) / 11; int sub = (ph - 1) % 11;
  if (ONLY_SUB >= 0) { if (sub != ONLY_SUB) return; sub = ONLY_SUB; }
  switch (sub) {
    case 0: ph_in_e(P, g, smem, s_rs); break;
    case 1: ph_mix_e(P, g, smem, s_item, rep); break;
    case 2: ph_out(P, 0, smem); break;
    case 3: ph_resid(P, g, 0); break;
    case 4: ph_ple(P, g, 0, smem); break;
    case 5: ph_in_o(P, g, smem, s_rs); break;
    case 6: ph_up(P, g, smem, s_rs); yt_fold(P, g); break;
    case 7: ph_mix_o(P, g, smem, rep == 0 ? 3 : MIXO_REP_PART, s_item, rep); break;
    case 8: ph_out(P, 1, smem); break;
    case 9: ph_resid(P, g, 1); break;
    default: ph_ple(P, g, 1, smem); break;
  }
}

__global__ void __launch_bounds__(NTHR, 2) mega(Params P, int ph_lo, int ph_hi, int rep0) {
  __shared__ __attribute__((aligned(16))) bf16_t smem[SMEM_E];
  __shared__ float s_rs[256];
  __shared__ int s_item;
  __shared__ uint4 xb_words;
  if (threadIdx.x == 0) xb_words = make_uint4(0u, 0u, 0u, 0u);
  __syncthreads();
  (void)xcd_barrier_post((unsigned*)(P.ws + OFF_BAR), (volatile LAS unsigned*)&xb_words);
  bool first_sync = true;
  for (int ph = ph_lo; ph < ph_hi; ph++) {
    const int sub = (ph == 0) ? 31 : (ph - 1) % 11;
    const int reps = 1 + ((REP_MASK >> sub) & 1);
    for (int rep = 0; rep < reps; rep++) {
      run_phase(P, ph, smem, s_rs, rep + rep0, &s_item);
      if (ph + 1 < ph_hi || rep + 1 < reps) {
        if (first_sync) { cg::this_grid().sync(); first_sync = false; } else { XcdBarrier xb; xb.bar = (unsigned*)(P.ws + OFF_BAR); xb.x = xb_xcc_id(); xb.st = (volatile LAS unsigned*)&xb_words; xcd_barrier(xb); }
      }
    }
  }
}

extern "C" void kernel_launch(void* const* d_in, const int* in_sizes, int n_in, void* d_out, int out_size, void* d_ws, size_t ws_size,
                              hipStream_t stream) {
  static int grid_blocks = 0;
  if (!grid_blocks) {
    int dev = 0, cus = 0, per_cu = 0;
    hipGetDevice(&dev);
    hipDeviceGetAttribute(&cus, hipDeviceAttributeMultiprocessorCount, dev);
    hipOccupancyMaxActiveBlocksPerMultiprocessor(&per_cu, mega, NTHR, 0);
    if (per_cu < 1) per_cu = 1;
    if (per_cu > 2) per_cu = 2;
    grid_blocks = cus * per_cu;
  }
  Params P{};
  P.x0 = (const float*)d_in[0]; P.x1 = (const float*)d_in[1]; P.p0 = (const float*)d_in[2]; P.p1 = (const float*)d_in[3];
  P.y0 = (float*)d_out; P.y1 = (float*)d_out + (size_t)TOK * 1024;
  P.g_pre = (const float*)d_in[4]; P.g_post = (const float*)d_in[5]; P.w_ple = (const float*)d_in[6]; P.w_ple_gate = (const float*)d_in[7];
  P.w_in_e = (const float*)d_in[8]; P.rpb = (const float*)d_in[9]; P.dw_w = (const float*)d_in[10]; P.dw_b = (const float*)d_in[11];
  P.cln_g = (const float*)d_in[12]; P.cln_b = (const float*)d_in[13]; P.w_out_e = (const float*)d_in[14]; P.w_in_o = (const float*)d_in[15];
  P.q_norm_g = (const float*)d_in[16]; P.kv_norm_g = (const float*)d_in[17]; P.w_uq = (const float*)d_in[18]; P.w_ukv = (const float*)d_in[19];
  P.w_out_o = (const float*)d_in[20];
  P.ws = (char*)d_ws;
  for (int i = 0; i < 16; i++) P.inv_freq[i] = powf(10000.0f, -(float)(2 * i) / 32.0f);
#if MK_COOP
  hipMemsetAsync((char*)d_ws + OFF_BAR, 0, XCD_BAR_WORDS * sizeof(unsigned), stream);
  int lo = 0, hi = NPH, rep0 = 0;
  void* args[] = {&P, &lo, &hi, &rep0};
  hipError_t e = hipLaunchCooperativeKernel((void*)mega, dim3(grid_blocks), dim3(NTHR), args, 0, stream);
  if (e != hipSuccess) fprintf(stderr, "cooperative launch failed: %s (grid %d)\n", hipGetErrorString(e), grid_blocks);
#else
#ifndef HOST_REP_MASK
#define HOST_REP_MASK 0u
#endif
  for (int ph = 0; ph < NPH; ph++) {
    mega<<<dim3(grid_blocks), dim3(NTHR), 0, stream>>>(P, ph, ph + 1, 0);
    const int sub = (ph == 0) ? 31 : (ph - 1) % 11;
    if ((HOST_REP_MASK >> sub) & 1u) mega<<<dim3(grid_blocks), dim3(NTHR), 0, stream>>>(P, ph, ph + 1, 1);
  }
#endif
}
```
